# Optimizing an MI355X kernel written in HIP

```python
import math
import jax, jax.numpy as jnp
from jax import lax
import numpy as np

D_MODEL = 2048
BATCH = 4
SEQ = 4096
DEPTH = 4

N_EVEN = (DEPTH + 1) // 2
N_ODD = DEPTH // 2

A_GROUPS = 8
A_DIM = 128
A_CHUNK = 128
A_WIDTH = A_GROUPS * A_DIM

B_HEADS = 4
B_DK = 128
B_DV = 256
B_RANK = 16
B_TAU = 16.0
B_CHUNK = 64
B_WIDTH = B_HEADS * B_DV

AB_OUT = A_WIDTH + B_WIDTH
AB_SPLITS = (A_WIDTH, A_WIDTH, B_HEADS * B_DK, B_HEADS * B_DK, B_WIDTH, B_WIDTH, B_RANK)
AB_IN = 2 * A_WIDTH + 2 * B_HEADS * B_DK + 2 * B_WIDTH + B_RANK

C_HEADS = 16
C_KV_HEADS = 4
C_HEAD_DIM = 128
C_IDX_HEADS = 16
C_IDX_DIM = 64
C_TOPK_MAX = 256
C_QBLOCK = 128
C_WIDTH = C_HEADS * C_HEAD_DIM
C_SPLITS = (C_WIDTH, C_KV_HEADS * C_HEAD_DIM, C_KV_HEADS * C_HEAD_DIM, C_IDX_HEADS * C_IDX_DIM, C_IDX_DIM, C_IDX_HEADS)
C_IN = C_WIDTH + 2 * C_KV_HEADS * C_HEAD_DIM + C_IDX_HEADS * C_IDX_DIM + C_IDX_DIM + C_IDX_HEADS

REL_BUCKETS = 32
REL_MAX_DIST = 128

D_FF = 4 * D_MODEL
EPS = 1e-6
F32 = jnp.float32

kernel_name = 'hybrid_sgu_gla_dsa_trunk'


def _offsets(sizes):
    out, acc = [], 0
    for s in sizes[:-1]:
        acc += s
        out.append(acc)
    return out


def _rmsnorm(x, g):
    xf = x.astype(F32)
    y = xf * lax.rsqrt(jnp.mean(xf * xf, axis=-1, keepdims=True) + EPS)
    return (y * g.astype(F32)).astype(x.dtype)


def _layernorm(x, g):
    xf = x.astype(F32)
    mu = jnp.mean(xf, axis=-1, keepdims=True)
    xc = xf - mu
    var = jnp.mean(xc * xc, axis=-1, keepdims=True)
    return (xc * lax.rsqrt(var + EPS) * g.astype(F32)).astype(x.dtype)


def _t5_bucket(dist):
    max_exact = REL_BUCKETS // 2
    d = jnp.maximum(dist, 1).astype(F32)
    large = max_exact + (jnp.log(d / max_exact) / math.log(REL_MAX_DIST / max_exact)
                         * (REL_BUCKETS - max_exact)).astype(jnp.int32)
    large = jnp.minimum(large, REL_BUCKETS - 1)
    return jnp.where(dist < max_exact, dist, large)


def _spatial_gating(u, v, ln_g, w_s, b_s):
    bsz, L = u.shape[:2]
    nc = L // A_CHUNK
    v = _layernorm(v, ln_g)
    v = v.reshape(bsz, nc, A_CHUNK, A_GROUPS, A_DIM)
    causal = jnp.tril(jnp.ones((A_CHUNK, A_CHUNK), dtype=bool))
    w = jnp.where(causal[None], w_s, jnp.zeros_like(w_s))
    z = jnp.einsum('gts,bnsgc->bntgc', w.astype(v.dtype), v) + b_s.T[:, :, None].astype(v.dtype)
    return u * z.reshape(bsz, L, A_GROUPS, A_DIM)


def _gla(q, k, v, log_a):
    bsz, L = q.shape[:2]
    nc = L // B_CHUNK

    def to_chunks(t):
        return t.astype(F32).reshape(bsz, nc, B_CHUNK, B_HEADS, t.shape[-1]).transpose(1, 0, 3, 2, 4)

    qc = to_chunks(q) * (B_DK ** -0.5)
    kc = to_chunks(k)
    vc = to_chunks(v)
    cum = jnp.cumsum(to_chunks(log_a), axis=3)
    last = cum[:, :, :, -1:, :]
    ref = 0.5 * last
    qe = qc * jnp.exp(cum - ref)
    ke = kc * jnp.exp(ref - cum)
    causal = jnp.tril(jnp.ones((B_CHUNK, B_CHUNK), dtype=bool))
    scores = jnp.where(causal, jnp.einsum('nbhid,nbhjd->nbhij', qe, ke), 0.0)
    o_intra = jnp.einsum('nbhij,nbhjv->nbhiv', scores, vc)
    q_inter = qc * jnp.exp(cum)
    k_state = kc * jnp.exp(last - cum)
    decay = jnp.exp(last[:, :, :, 0, :])

    def step(S, inp):
        qi, ki, vi, di = inp
        o = jnp.einsum('bhid,bhdv->bhiv', qi, S)
        S = di[..., None] * S + jnp.einsum('bhjd,bhjv->bhdv', ki, vi)
        return S, o

    S0 = jnp.zeros((bsz, B_HEADS, B_DK, B_DV), F32)
    _, o_inter = lax.scan(step, S0, (q_inter, k_state, vc, decay))
    o = o_intra + o_inter
    return o.transpose(1, 0, 3, 2, 4).reshape(bsz, L, B_HEADS, B_DV)


def _dsa_attention(q, k, v, iq, ik, iw, rel_bias):
    bsz, L = q.shape[:2]
    k_sel = min(C_TOPK_MAX, L // 4)
    nb = L // C_QBLOCK
    grp = C_HEADS // C_KV_HEADS
    key_pos = jnp.arange(L, dtype=jnp.int32)
    ik32 = ik.astype(F32)

    def blocks(t):
        return t.reshape(bsz, nb, C_QBLOCK, *t.shape[2:]).swapaxes(0, 1)

    def one_block(inp):
        qb, iqb, iwb, start = inp
        qpos = start + jnp.arange(C_QBLOCK, dtype=jnp.int32)
        s = jnp.einsum('bthd,bsd->bths', iqb.astype(F32), ik32) * (C_IDX_DIM ** -0.5)
        score = jnp.einsum('bths,bth->bts', jax.nn.relu(s), iwb.astype(F32)) * (C_IDX_HEADS ** -0.5)
        causal = key_pos[None, :] <= qpos[:, None]
        score = jnp.where(causal[None], score, -jnp.inf)
        _, idx = lax.top_k(score, k_sel)
        valid = idx <= qpos[None, :, None]
        kg = jax.vmap(lambda kb, ib: kb[ib])(k, idx)
        vg = jax.vmap(lambda vb, ib: vb[ib])(v, idx)
        qg = qb.reshape(bsz, C_QBLOCK, C_KV_HEADS, grp, C_HEAD_DIM)
        logits = jnp.einsum('btkgd,btskd->btkgs', qg, kg).astype(F32) * (C_HEAD_DIM ** -0.5)
        dist = jnp.maximum(qpos[None, :, None] - idx, 0)
        bias = rel_bias.astype(F32)[_t5_bucket(dist)]
        bias = bias.reshape(bsz, C_QBLOCK, k_sel, C_KV_HEADS, grp).transpose(0, 1, 3, 4, 2)
        logits = jnp.where(valid[:, :, None, None, :], logits + bias, -jnp.inf)
        p = jax.nn.softmax(logits, axis=-1)
        o = jnp.einsum('btkgs,btskd->btkgd', p.astype(vg.dtype), vg)
        return o.reshape(bsz, C_QBLOCK, C_WIDTH)

    starts = jnp.arange(nb, dtype=jnp.int32) * C_QBLOCK
    out = lax.map(one_block, (blocks(q), blocks(iq), blocks(iw), starts))
    return out.swapaxes(0, 1).reshape(bsz, L, C_WIDTH)


def _even_mixer(h, w_in, v_ln_g, w_s, b_s, gate_w2, gate_b, out_norm_g, w_out):
    bsz, L, _ = h.shape
    p = h @ w_in
    a_u, a_v, q, k, v, r, g_lr = jnp.split(p, _offsets(AB_SPLITS), axis=-1)
    a_u = jax.nn.gelu(a_u, approximate=False).reshape(bsz, L, A_GROUPS, A_DIM)
    a_v = jax.nn.gelu(a_v, approximate=False).reshape(bsz, L, A_GROUPS, A_DIM)
    a_out = _spatial_gating(a_u, a_v, v_ln_g, w_s, b_s).reshape(bsz, L, A_WIDTH)
    log_a = jax.nn.log_sigmoid((g_lr @ gate_w2 + gate_b).astype(F32)) / B_TAU
    o = _gla(q.reshape(bsz, L, B_HEADS, B_DK), k.reshape(bsz, L, B_HEADS, B_DK),
             v.reshape(bsz, L, B_HEADS, B_DV), log_a.reshape(bsz, L, B_HEADS, B_DK))
    o = _rmsnorm(o, out_norm_g) * jax.nn.silu(r.astype(F32)).reshape(bsz, L, B_HEADS, B_DV)
    b_out = o.reshape(bsz, L, B_WIDTH).astype(h.dtype)
    return jnp.concatenate([a_out, b_out], axis=-1) @ w_out


def _odd_mixer(h, w_in, w_out, rel_bias):
    bsz, L, _ = h.shape
    p = h @ w_in
    q, k, v, iq, ik, iw = jnp.split(p, _offsets(C_SPLITS), axis=-1)
    o = _dsa_attention(q.reshape(bsz, L, C_HEADS, C_HEAD_DIM),
                       k.reshape(bsz, L, C_KV_HEADS, C_HEAD_DIM),
                       v.reshape(bsz, L, C_KV_HEADS, C_HEAD_DIM),
                       iq.reshape(bsz, L, C_IDX_HEADS, C_IDX_DIM), ik, iw, rel_bias)
    return o @ w_out


def _sqrelu_mlp(h, w1, w2):
    return jnp.square(jax.nn.relu(h @ w1)) @ w2


def setup_inputs(seed: int = 0) -> dict:
    key = jax.random.key(seed)
    ks = jax.random.split(key, 17)

    def nrm(k, shape, scale):
        return jax.random.normal(k, shape, F32) * scale

    row_scale = (jnp.arange(A_CHUNK, dtype=F32) + 1.0) ** -0.5
    return {
        'x': nrm(ks[0], (BATCH, SEQ, D_MODEL), 1.0),
        'norm_mix_g': 1.0 + nrm(ks[1], (DEPTH, D_MODEL), 0.02),
        'norm_ffn_g': 1.0 + nrm(ks[2], (DEPTH, D_MODEL), 0.02),
        'final_norm_g': 1.0 + nrm(ks[3], (D_MODEL,), 0.02),
        'ab_w_in': nrm(ks[4], (N_EVEN, D_MODEL, AB_IN), D_MODEL ** -0.5),
        'a_v_ln_g': 1.0 + nrm(ks[5], (N_EVEN, A_GROUPS, A_DIM), 0.02),
        'a_w_s': nrm(ks[6], (N_EVEN, A_GROUPS, A_CHUNK, A_CHUNK), 1.0) * row_scale[:, None],
        'a_b_s': nrm(ks[7], (N_EVEN, A_GROUPS, A_CHUNK), 0.02),
        'b_gate_w2': nrm(ks[8], (N_EVEN, B_RANK, B_HEADS * B_DK), B_RANK ** -0.5),
        'b_gate_b': nrm(ks[9], (N_EVEN, B_HEADS * B_DK), 0.02),
        'b_out_norm_g': 1.0 + nrm(ks[10], (N_EVEN, B_DV), 0.02),
        'ab_w_out': nrm(ks[11], (N_EVEN, AB_OUT, D_MODEL), AB_OUT ** -0.5),
        'c_w_in': nrm(ks[12], (N_ODD, D_MODEL, C_IN), D_MODEL ** -0.5),
        'c_w_out': nrm(ks[13], (N_ODD, C_WIDTH, D_MODEL), C_WIDTH ** -0.5),
        'rel_bias': nrm(ks[14], (REL_BUCKETS, C_HEADS), 0.2),
        'ffn_w1': nrm(ks[15], (DEPTH, D_MODEL, D_FF), D_MODEL ** -0.5),
        'ffn_w2': nrm(ks[16], (DEPTH, D_FF, D_MODEL), D_FF ** -0.5),
    }


def reference(x, norm_mix_g, norm_ffn_g, final_norm_g, ab_w_in, a_v_ln_g, a_w_s, a_b_s,
              b_gate_w2, b_gate_b, b_out_norm_g, ab_w_out, c_w_in, c_w_out, rel_bias,
              ffn_w1, ffn_w2):
    h = x
    for layer in range(DEPTH):
        i = layer // 2
        hn = _rmsnorm(h, norm_mix_g[layer])
        if layer % 2 == 0:
            mix = _even_mixer(hn, ab_w_in[i], a_v_ln_g[i], a_w_s[i], a_b_s[i], b_gate_w2[i],
                              b_gate_b[i], b_out_norm_g[i], ab_w_out[i])
        else:
            mix = _odd_mixer(hn, c_w_in[i], c_w_out[i], rel_bias)
        h = h + mix.astype(h.dtype)
        hn = _rmsnorm(h, norm_ffn_g[layer])
        h = h + _sqrelu_mlp(hn, ffn_w1[layer], ffn_w2[layer]).astype(h.dtype)
    return _rmsnorm(h, final_norm_g)
```

```cpp
#include <hip/hip_runtime.h>
#include <cstdio>
#include <cstdint>
namespace pg8 {
#define PG8_LAS __attribute__((address_space(3)))
typedef unsigned short bf16_t;
typedef short bf16x8 __attribute__((ext_vector_type(8)));
typedef float f32x4 __attribute__((ext_vector_type(4)));
typedef unsigned u32x4 __attribute__((ext_vector_type(4)));
#ifndef PG8_WIDE
#define PG8_WIDE 1
#endif
#define PG8_BJ (PG8_WIDE ? 8 : HALF)
constexpr int BM = 256, BK = 64, HALF = 128, HTB = HALF * BK * 2  , STAGE_BYTES = 8 * HTB, NXCD = 8, WGM = 8;

__host__ __device__ __forceinline__ int lds_byte(int r, int c) { const int st = (r >> 4) * 2 + (c >> 5), rr = r & 15, cc = c & 31, ob = rr * 64 + cc * 2; return st * 1024 + (ob ^ (((ob >> 9) & 1) << 5)); }
__host__ __device__ __forceinline__ void stage_rc(int b, int& R, int& C) { const int st = b / 1024, sb = b % 1024, swz = sb ^ (((sb >> 9) & 1) << 5); R = (st >> 1) * 16 + swz / 64; C = (st & 1) * 32 + (swz % 64) / 2; }
__host__ __device__ __forceinline__ int perm32(int rho) { const int n = rho >> 4, i = rho & 15; return 8 * (i >> 2) + 4 * n + (i & 3); }

struct Unit { int pm, pn; };
struct Gemm { const bf16_t* A; const bf16_t* Bt; int M, N, K; int wscale = 127 - 10; };

struct StaticOrder {
    int nM, nN, nwg, G, c;
    __host__ __device__ void init(int M, int N, int G_, int c_) { nM = M / BM; nN = N / BM; nwg = nM * nN; G = G_; c = c_; }
    __host__ __device__ bool next(int i, Unit& u) const {
        const long L = (long)i * G + c; if (L >= nwg) return false;
        int wgid = (int)L; { const int q = nwg / NXCD, r = nwg % NXCD, xcd = wgid % NXCD, off = wgid / NXCD; wgid = (xcd < r ? xcd * (q + 1) : r * (q + 1) + (xcd - r) * q) + off; }
        const int nig = WGM * nN, gid = wgid / nig, fm = gid * WGM, gsz = (nM - fm) < WGM ? (nM - fm) : WGM;
        u.pm = fm + ((wgid % nig) % gsz); u.pn = (wgid % nig) / gsz; return true;
    }
    __device__ __forceinline__ void a_ready(const Unit&) const {}
    __device__ __forceinline__ void done(const Unit&) const {}
};

__device__ __forceinline__ unsigned cvt_pk_bf16(float lo, float hi) { unsigned r; asm volatile("v_cvt_pk_bf16_f32 %0, %1, %2" : "=v"(r) : "v"(lo), "v"(hi)); return r; }
typedef float f32x2 __attribute__((ext_vector_type(2)));
#ifndef WT_STORES
#define WT_STORES 0
#endif
__device__ __forceinline__ void store16_wt(void* p, u32x4 v) {
#if WT_STORES == 1
    asm volatile("global_store_dwordx4 %0, %1, off sc1\n\ts_nop 1" :: "v"(p), "v"(v));
#elif WT_STORES == 2
    __builtin_nontemporal_store(v, (u32x4*)p);
#else
    *(u32x4*)p = v;
#endif
}
__device__ __forceinline__ f32x2 gelu_pk(f32x2 v) {
    const f32x2 av = __builtin_elementwise_abs(v), d = av * 0.2316418882f + 1.0f;
    f32x2 t; t.x = __builtin_amdgcn_rcpf(d.x); t.y = __builtin_amdgcn_rcpf(d.y);
    f32x2 q = t * 0.5307027145f + (-0.7265760135f); q = q * t + 0.7107068705f; q = q * t + (-0.142248368f); q = q * t + 0.127414796f; q = q * t;
    const f32x2 s = (v * v) * (-0.72134752044f);
    f32x2 e; e.x = __builtin_amdgcn_exp2f(s.x); e.y = __builtin_amdgcn_exp2f(s.y);
    const f32x2 m = v * (q * e), r = v - m;
    f32x2 o; o.x = v.x < 0.f ? m.x : r.x; o.y = v.y < 0.f ? m.y : r.y; return o;
}

constexpr float RSS_SCALE = 65536.f, RSS_INV = 1.f / (65536.f * 2048.f), NORM_EPS = 1e-6f;
struct PreRss { unsigned long long v[2][4]; };
struct PreNone {};
__device__ __forceinline__ void prefetch_rss(PreRss& p, const unsigned long long* rss, int row0) {
#pragma unroll
    for (int ai = 0; ai < 2; ++ai)
#pragma unroll
        for (int m = 0; m < 4; ++m) asm volatile("global_load_dwordx2 %0, %1, off" : "=&v"(p.v[ai][m]) : "v"(rss + row0 + ai * HALF + m * 16) : "memory");
}
__device__ __forceinline__ void load_rstd(PreRss& p, float (&rs)[2][4]) {
    asm volatile("s_waitcnt vmcnt(16)" : "+v"(p.v[0][0]), "+v"(p.v[0][1]), "+v"(p.v[0][2]), "+v"(p.v[0][3]), "+v"(p.v[1][0]), "+v"(p.v[1][1]), "+v"(p.v[1][2]), "+v"(p.v[1][3]) :: "memory");
#pragma unroll
    for (int ai = 0; ai < 2; ++ai)
#pragma unroll
        for (int m = 0; m < 4; ++m) rs[ai][m] = rsqrtf((float)p.v[ai][m] * RSS_INV + NORM_EPS);
}
struct EpiInProj {
    static constexpr bool PERM = true, AFTER_DRAIN = false;
    bf16_t* O; int ldc; int gelu_cols; const unsigned long long* rss;
    typedef PreRss Pre;
    __device__ __forceinline__ void prefetch(Pre& p, const Unit& u, int wr, int fr) const { prefetch_rss(p, rss, u.pm * BM + wr * 64 + fr); }
    __device__ __forceinline__ void operator()(const f32x4 (&acc)[2][2][4][2], const Unit& u, int wr, int wc, int fr, int fq, Pre& pre) const {
        const int row0 = u.pm * BM + wr * 64 + fr, col0 = u.pn * BM + (PG8_WIDE ? wc * 64 + 16 * fq : wc * 32 + 8 * fq);
        const bool g = (u.pn * BM) < gelu_cols;
        float rs[2][4]; load_rstd(pre, rs);
#pragma unroll
        for (int ai = 0; ai < 2; ++ai)
#pragma unroll
            for (int m = 0; m < 4; ++m) { bf16_t* rowp = O + (size_t)(row0 + ai * HALF + m * 16) * ldc + col0;
#pragma unroll
                for (int bj = 0; bj < 2; ++bj) { f32x4 v0 = acc[ai][bj][m][0] * rs[ai][m], v1 = acc[ai][bj][m][1] * rs[ai][m];
                    if (g) { f32x2 a = gelu_pk((f32x2){v0[0], v0[1]}), b = gelu_pk((f32x2){v0[2], v0[3]}), c = gelu_pk((f32x2){v1[0], v1[1]}), d = gelu_pk((f32x2){v1[2], v1[3]});
                        v0 = (f32x4){a.x, a.y, b.x, b.y}; v1 = (f32x4){c.x, c.y, d.x, d.y}; }
                    u32x4 w; w.x = cvt_pk_bf16(v0[0], v0[1]); w.y = cvt_pk_bf16(v0[2], v0[3]); w.z = cvt_pk_bf16(v1[0], v1[1]); w.w = cvt_pk_bf16(v1[2], v1[3]);
                    store16_wt(rowp + bj * PG8_BJ, w); } }
    }
};
struct EpiRelu2 {
    static constexpr bool PERM = true, AFTER_DRAIN = false;
    bf16_t* O; int ldc; const unsigned long long* rss;
    typedef PreRss Pre;
    __device__ __forceinline__ void prefetch(Pre& p, const Unit& u, int wr, int fr) const { prefetch_rss(p, rss, u.pm * BM + wr * 64 + fr); }
    __device__ __forceinline__ void operator()(const f32x4 (&acc)[2][2][4][2], const Unit& u, int wr, int wc, int fr, int fq, Pre& pre) const {
        const int row0 = u.pm * BM + wr * 64 + fr, col0 = u.pn * BM + (PG8_WIDE ? wc * 64 + 16 * fq : wc * 32 + 8 * fq);
        float rs[2][4]; load_rstd(pre, rs);
#pragma unroll
        for (int ai = 0; ai < 2; ++ai)
#pragma unroll
            for (int m = 0; m < 4; ++m) { bf16_t* rowp = O + (size_t)(row0 + ai * HALF + m * 16) * ldc + col0;
#pragma unroll
                for (int bj = 0; bj < 2; ++bj) { f32x4 v0 = acc[ai][bj][m][0] * rs[ai][m], v1 = acc[ai][bj][m][1] * rs[ai][m];
#pragma unroll
                    for (int j = 0; j < 4; ++j) { const float a = fmaxf(v0[j], 0.f), b = fmaxf(v1[j], 0.f); v0[j] = a * a; v1[j] = b * b; }
                    u32x4 w; w.x = cvt_pk_bf16(v0[0], v0[1]); w.y = cvt_pk_bf16(v0[2], v0[3]); w.z = cvt_pk_bf16(v1[0], v1[1]); w.w = cvt_pk_bf16(v1[2], v1[3]);
                    store16_wt(rowp + bj * PG8_BJ, w); } }
    }
};
typedef int i32x8 __attribute__((ext_vector_type(8)));
typedef int i32x4 __attribute__((ext_vector_type(4)));
__device__ __forceinline__ i32x8 cat_f8(bf16x8 a, bf16x8 b) { return __builtin_shufflevector(__builtin_bit_cast(i32x4, a), __builtin_bit_cast(i32x4, b), 0, 1, 2, 3, 4, 5, 6, 7); }
constexpr float F8_MAX = 448.f;
constexpr int F8_WSCALE_E8M0 = 127 - 10;
__device__ __forceinline__ unsigned pk4_fp8(float a, float b, float c, float d) {
    int r = __builtin_amdgcn_cvt_pk_fp8_f32(a, b, 0, false); r = __builtin_amdgcn_cvt_pk_fp8_f32(c, d, r, true); return (unsigned)r; }
typedef unsigned u32x2 __attribute__((ext_vector_type(2)));
__device__ __forceinline__ void mfma_f8_acc(f32x4& acc, i32x8 a, i32x8 b, int sc) {
    asm volatile("v_mfma_scale_f32_16x16x128_f8f6f4 %0, %1, %2, %0, %3, %3 op_sel:[0,1,0] op_sel_hi:[0,0,0]" : "+v"(acc) : "v"(a), "v"(b), "v"(sc));
}
struct EpiRelu2F8 {
    static constexpr bool PERM = true, AFTER_DRAIN = false;
    unsigned char* O; int ldc; const unsigned long long* rss;
    typedef PreRss Pre;
    __device__ __forceinline__ void prefetch(Pre& p, const Unit& u, int wr, int fr) const { prefetch_rss(p, rss, u.pm * BM + wr * 64 + fr); }
    __device__ __forceinline__ void operator()(const f32x4 (&acc)[2][2][4][2], const Unit& u, int wr, int wc, int fr, int fq, Pre& pre) const {
        const int row0 = u.pm * BM + wr * 64 + fr, col0 = u.pn * BM + (PG8_WIDE ? wc * 64 + 16 * fq : wc * 32 + 8 * fq);
        float rs[2][4]; load_rstd(pre, rs);
#pragma unroll
        for (int ai = 0; ai < 2; ++ai)
#pragma unroll
            for (int m = 0; m < 4; ++m) { unsigned char* rowp = O + (size_t)(row0 + ai * HALF + m * 16) * ldc + col0; u32x4 w4;
#pragma unroll
                for (int bj = 0; bj < 2; ++bj) { f32x4 v0 = acc[ai][bj][m][0] * rs[ai][m], v1 = acc[ai][bj][m][1] * rs[ai][m];
#pragma unroll
                    for (int j = 0; j < 4; ++j) { const float a = fmaxf(v0[j], 0.f), b = fmaxf(v1[j], 0.f); v0[j] = fminf(a * a, F8_MAX); v1[j] = fminf(b * b, F8_MAX); }
                    u32x2 w; w.x = pk4_fp8(v0[0], v0[1], v0[2], v0[3]); w.y = pk4_fp8(v1[0], v1[1], v1[2], v1[3]);
                    if (PG8_WIDE) { if (bj == 0) { w4.x = w.x; w4.y = w.y; } else { w4.z = w.x; w4.w = w.y; } } else *(u32x2*)(rowp + bj * PG8_BJ) = w; }
                if (PG8_WIDE) *(u32x4*)rowp = w4; }
    }
};
struct EpiNull {
    static constexpr bool PERM = true, AFTER_DRAIN = false;
    bf16_t* O;
    typedef PreNone Pre;
    __device__ __forceinline__ void prefetch(Pre&, const Unit&, int, int) const {}
    __device__ __forceinline__ void operator()(const f32x4 (&acc)[2][2][4][2], const Unit& u, int wr, int wc, int fr, int fq, Pre&) const {
        float s = 0.f;
#pragma unroll
        for (int ai = 0; ai < 2; ++ai)
#pragma unroll
            for (int bj = 0; bj < 2; ++bj)
#pragma unroll
                for (int m = 0; m < 4; ++m)
#pragma unroll
                    for (int n = 0; n < 2; ++n) s += (acc[ai][bj][m][n][0] + acc[ai][bj][m][n][1]) + (acc[ai][bj][m][n][2] + acc[ai][bj][m][n][3]);
        if (s == 1.2345678e30f) O[(size_t)(u.pm * BM + wr * 64 + fr) * 8192 + u.pn * BM + wc * 32 + 8 * fq] = (bf16_t)1;
    }
};
template <bool LAST, bool H8 = false> struct EpiResBf16 {
    static constexpr bool PERM = true, AFTER_DRAIN = false;
    bf16_t* hb; int ldc; unsigned long long* rss_out; float* out; unsigned char* h8 = nullptr;
    typedef PreNone Pre;
    __device__ __forceinline__ void prefetch(Pre&, const Unit&, int, int) const {}
    __device__ __forceinline__ void operator()(const f32x4 (&acc)[2][2][4][2], const Unit& u, int wr, int wc, int fr, int fq, Pre&) const {
        const int row0 = u.pm * BM + wr * 64 + fr, col0 = u.pn * BM + (PG8_WIDE ? wc * 64 + 16 * fq : wc * 32 + 8 * fq);
#pragma unroll
        for (int ai = 0; ai < 2; ++ai)
#pragma unroll
            for (int m = 0; m < 4; ++m) { const int row = row0 + ai * HALF + m * 16; const size_t off = (size_t)row * ldc + col0; float ss = 0.f;
#pragma unroll
                for (int bj = 0; bj < 2; ++bj) { const u32x4 r = *(const u32x4*)(hb + off + bj * PG8_BJ);
                    f32x4 o0 = acc[ai][bj][m][0], o1 = acc[ai][bj][m][1];
                    o0[0] += __builtin_bit_cast(float, r.x << 16); o0[1] += __builtin_bit_cast(float, r.x & 0xffff0000u); o0[2] += __builtin_bit_cast(float, r.y << 16); o0[3] += __builtin_bit_cast(float, r.y & 0xffff0000u);
                    o1[0] += __builtin_bit_cast(float, r.z << 16); o1[1] += __builtin_bit_cast(float, r.z & 0xffff0000u); o1[2] += __builtin_bit_cast(float, r.w << 16); o1[3] += __builtin_bit_cast(float, r.w & 0xffff0000u);
                    if (LAST) { *(f32x4*)(out + off + bj * PG8_BJ) = o0; *(f32x4*)(out + off + bj * PG8_BJ + 4) = o1; ss += (o0[0] * o0[0] + o0[1] * o0[1]) + (o0[2] * o0[2] + o0[3] * o0[3]) + (o1[0] * o1[0] + o1[1] * o1[1]) + (o1[2] * o1[2] + o1[3] * o1[3]); }
                    else { u32x4 w; w.x = cvt_pk_bf16(o0[0], o0[1]); w.y = cvt_pk_bf16(o0[2], o0[3]); w.z = cvt_pk_bf16(o1[0], o1[1]); w.w = cvt_pk_bf16(o1[2], o1[3]); store16_wt(hb + off + bj * PG8_BJ, w);
                        const float q0 = __builtin_bit_cast(float, w.x << 16), q1 = __builtin_bit_cast(float, w.x & 0xffff0000u), q2 = __builtin_bit_cast(float, w.y << 16), q3 = __builtin_bit_cast(float, w.y & 0xffff0000u);
                        const float q4 = __builtin_bit_cast(float, w.z << 16), q5 = __builtin_bit_cast(float, w.z & 0xffff0000u), q6 = __builtin_bit_cast(float, w.w << 16), q7 = __builtin_bit_cast(float, w.w & 0xffff0000u);
                        ss += (q0 * q0 + q1 * q1) + (q2 * q2 + q3 * q3) + (q4 * q4 + q5 * q5) + (q6 * q6 + q7 * q7);
                        if constexpr (H8) { u32x2 w8; w8.x = pk4_fp8(fminf(fmaxf(q0, -F8_MAX), F8_MAX), fminf(fmaxf(q1, -F8_MAX), F8_MAX), fminf(fmaxf(q2, -F8_MAX), F8_MAX), fminf(fmaxf(q3, -F8_MAX), F8_MAX));
                            w8.y = pk4_fp8(fminf(fmaxf(q4, -F8_MAX), F8_MAX), fminf(fmaxf(q5, -F8_MAX), F8_MAX), fminf(fmaxf(q6, -F8_MAX), F8_MAX), fminf(fmaxf(q7, -F8_MAX), F8_MAX));
                            *(u32x2*)(h8 + off + bj * PG8_BJ) = w8; } } }
                ss += __shfl_xor(ss, 16); ss += __shfl_xor(ss, 32);
                if (fq == 0) atomicAdd(rss_out + row, (unsigned long long)(ss * RSS_SCALE + 0.5f)); }
    }
};
template <class Epi, class Sched, bool ALIGN_EPI = false, bool SP2 = false, bool F8 = false>
__device__ __forceinline__ void gemm_phase(PG8_LAS unsigned char* lds, const Gemm g, const Sched& S, const Epi& E) {
    int tid_ = threadIdx.x; asm volatile("" : "+v"(tid_));
    const int tid = tid_, wid = __builtin_amdgcn_readfirstlane(tid >> 6), lane = tid & 63, wr = wid >> 2, wc = wid & 3, fr = lane & 15, fq = lane >> 4;
    const int K = g.K, KB = F8 ? K : 2 * K  , nt = KB / (BK * 2);
    unsigned voffA[2], voffB[2];
#pragma unroll
    for (int i = 0; i < 2; ++i) { int R, C; stage_rc(tid * 16 + i * 8192, R, C); const int Rb = !Epi::PERM ? R : PG8_WIDE ? 64 * (R >> 5) + 16 * ((R & 15) >> 2) + 4 * ((R >> 4) & 1) + (R & 3) : ((R & ~31) + perm32(R & 31));
        voffA[i] = (unsigned)(R * KB + C * 2); voffB[i] = (unsigned)(Rb * KB + C * 2); }
    const size_t kstep = (size_t)(BK * 2);
    const size_t hstep = (size_t)HALF * KB;
    const size_t tstep = 2 * hstep;
    const size_t bhstep = (Epi::PERM && PG8_WIDE) ? (size_t)8 * KB : hstep;
    const unsigned ldsw = (unsigned)wid * 1024u;
    const int aoff = lds_byte(wr * 64 + fr, fq * 8), boff = lds_byte(wc * 32 + fr, fq * 8);
#define PG8_SA(b, h) (((b) * 2 + (h)) * HTB)
#define PG8_SB(b, h) ((4 + (b) * 2 + (h)) * HTB)
#define PG8_STAGE(bufoff, gbase, voff) do { _Pragma("unroll") for (int _i = 0; _i < 2; ++_i) \
        __builtin_amdgcn_global_load_lds((const unsigned*)((const char*)(gbase) + (voff)[_i]), (PG8_LAS unsigned*)(lds + (bufoff) + ldsw + _i * 8192), 16, 0, 0); } while (0)
#define PG8_LDA(dst, b, h) do { _Pragma("unroll") for (int m = 0; m < 4; ++m) _Pragma("unroll") for (int k = 0; k < 2; ++k) dst[m][k] = *(const PG8_LAS bf16x8*)(lds + PG8_SA(b, h) + aoff + m * 2048 + k * 1024); } while (0)
#define PG8_LDB(dst, b, h) do { _Pragma("unroll") for (int n = 0; n < 2; ++n) _Pragma("unroll") for (int k = 0; k < 2; ++k) dst[n][k] = *(const PG8_LAS bf16x8*)(lds + PG8_SB(b, h) + boff + n * 2048 + k * 1024); } while (0)
#define PG8_MMA(ai, bj, At, Bt) do { __builtin_amdgcn_s_setprio(1); _Pragma("unroll") for (int m = 0; m < 4; ++m) _Pragma("unroll") for (int n = 0; n < 2; ++n) { \
        if constexpr (F8) mfma_f8_acc(acc[ai][bj][m][n], cat_f8(Bt[n][0], Bt[n][1]), cat_f8(At[m][0], At[m][1]), f8_sc); \
        else { _Pragma("unroll") for (int k = 0; k < 2; ++k) acc[ai][bj][m][n] = __builtin_amdgcn_mfma_f32_16x16x32_bf16(Bt[n][k], At[m][k], acc[ai][bj][m][n], 0, 0, 0); } } \
        __builtin_amdgcn_s_setprio(0); } while (0)
#define PG8_WAIT_V(n) asm volatile("s_waitcnt vmcnt(" #n ")" ::: "memory")
#define PG8_WAIT_L(n) asm volatile("s_waitcnt lgkmcnt(" #n ")" ::: "memory")
#define PG8_BAR __builtin_amdgcn_s_barrier()
#define PG8_SCHED __builtin_amdgcn_sched_barrier(0)
    Unit cur, nxt; int ui = 0;
    if (!S.next(0, cur)) return;
    f32x4 acc[2][2][4][2];
#pragma unroll
    for (int a = 0; a < 2; ++a)
#pragma unroll
        for (int b = 0; b < 2; ++b)
#pragma unroll
            for (int m = 0; m < 4; ++m)
#pragma unroll
                for (int n = 0; n < 2; ++n) acc[a][b][m][n] = (f32x4){0.f, 0.f, 0.f, 0.f};
    bf16x8 At[4][2], B0[2][2], B1[2][2];
    int f8_sc = g.wscale | (127 << 8); if constexpr (F8) asm volatile("" : "+v"(f8_sc));
    typename Epi::Pre pre;
    const char* cA = (const char*)g.A + (size_t)cur.pm * tstep; const char* cB = (const char*)g.Bt + (size_t)cur.pn * tstep;
    S.a_ready(cur);
    if constexpr (SP2) {
        PG8_STAGE(PG8_SB(0, 0), cB, voffB); PG8_STAGE(PG8_SB(0, 1), cB + bhstep, voffB); PG8_STAGE(PG8_SA(0, 0), cA, voffA); PG8_STAGE(PG8_SA(0, 1), cA + hstep, voffA);
        if (wr == 1) PG8_BAR;
        PG8_WAIT_V(2); PG8_BAR;
        PG8_STAGE(PG8_SB(1, 0), cB + kstep, voffB); PG8_STAGE(PG8_SA(1, 0), cA + kstep, voffA); PG8_STAGE(PG8_SB(1, 1), cB + bhstep + kstep, voffB);
        PG8_WAIT_V(6); PG8_BAR;
    } else {
        PG8_STAGE(PG8_SB(0, 0), cB, voffB); PG8_STAGE(PG8_SA(0, 0), cA, voffA); PG8_STAGE(PG8_SB(0, 1), cB + bhstep, voffB); PG8_STAGE(PG8_SA(0, 1), cA + hstep, voffA);
        if (wr == 1) PG8_BAR;
        PG8_WAIT_V(4); PG8_BAR;
        PG8_STAGE(PG8_SB(1, 0), cB + kstep, voffB); PG8_STAGE(PG8_SA(1, 0), cA + kstep, voffA); PG8_STAGE(PG8_SB(1, 1), cB + bhstep + kstep, voffB);
        PG8_WAIT_V(6); PG8_BAR;
    }
    for (;;) {
        const bool has_next = S.next(ui + 1, nxt);
        const char* nA = has_next ? (const char*)g.A + (size_t)nxt.pm * tstep : cA; const char* nB = has_next ? (const char*)g.Bt + (size_t)nxt.pn * tstep : cB;
        for (int t = 0; t < nt; t += 2) {
            const bool last = (t == nt - 2);
            const char* a1 = cA + (size_t)(t + 1) * kstep;
            const char* a2 = last ? nA : cA + (size_t)(t + 2) * kstep; const char* b2 = last ? nB : cB + (size_t)(t + 2) * kstep;
            const char* a3 = a2 + kstep; const char* b3 = b2 + kstep;
            if (last && has_next) S.a_ready(nxt);
            if (last) E.prefetch(pre, cur, wr, fr);
            if constexpr (SP2) {
            PG8_LDB(B0, 0, 0); PG8_LDB(B1, 0, 1); PG8_SCHED; PG8_LDA(At, 0, 0); PG8_STAGE(PG8_SA(1, 1), a1 + hstep, voffA);
            PG8_WAIT_V(8); PG8_WAIT_L(0); PG8_BAR; PG8_MMA(0, 0, At, B0); PG8_MMA(0, 1, At, B1); PG8_BAR; PG8_SCHED;
            PG8_LDA(At, 0, 1); PG8_STAGE(PG8_SB(0, 0), b2, voffB); PG8_STAGE(PG8_SB(0, 1), b2 + bhstep, voffB); PG8_STAGE(PG8_SA(0, 0), a2, voffA);
            PG8_WAIT_V(8); PG8_WAIT_L(0); PG8_BAR; PG8_MMA(1, 0, At, B0); PG8_MMA(1, 1, At, B1); PG8_BAR; PG8_SCHED;
            PG8_LDB(B0, 1, 0); PG8_LDB(B1, 1, 1); PG8_SCHED; PG8_LDA(At, 1, 0); PG8_STAGE(PG8_SA(0, 1), a2 + hstep, voffA);
            PG8_WAIT_V(8); PG8_WAIT_L(0); PG8_BAR; PG8_MMA(0, 0, At, B0); PG8_MMA(0, 1, At, B1); PG8_BAR; PG8_SCHED;
            PG8_LDA(At, 1, 1); PG8_STAGE(PG8_SB(1, 0), b3, voffB); PG8_STAGE(PG8_SB(1, 1), b3 + bhstep, voffB); PG8_STAGE(PG8_SA(1, 0), a3, voffA);
            PG8_WAIT_V(8); PG8_WAIT_L(0); PG8_BAR; PG8_MMA(1, 0, At, B0); PG8_MMA(1, 1, At, B1); PG8_BAR; PG8_SCHED;
            } else {
            PG8_LDB(B0, 0, 0); PG8_SCHED; PG8_LDA(At, 0, 0); PG8_STAGE(PG8_SA(1, 1), a1 + hstep, voffA);
            PG8_WAIT_L(8); PG8_BAR; PG8_WAIT_L(0); PG8_MMA(0, 0, At, B0); PG8_BAR; PG8_SCHED;
            PG8_LDB(B1, 0, 1); PG8_STAGE(PG8_SB(0, 0), b2, voffB);
            PG8_BAR; PG8_WAIT_L(0); PG8_MMA(0, 1, At, B1); PG8_BAR;
            PG8_LDA(At, 0, 1); PG8_STAGE(PG8_SA(0, 0), a2, voffA);
            PG8_BAR; PG8_WAIT_L(0); PG8_MMA(1, 0, At, B0); PG8_BAR; PG8_SCHED;
            PG8_STAGE(PG8_SB(0, 1), b2 + bhstep, voffB);
            PG8_WAIT_V(6); PG8_BAR; PG8_MMA(1, 1, At, B1); PG8_BAR;
            PG8_LDB(B0, 1, 0); PG8_SCHED; PG8_LDA(At, 1, 0); PG8_STAGE(PG8_SA(0, 1), a2 + hstep, voffA);
            PG8_WAIT_L(8); PG8_BAR; PG8_WAIT_L(0); PG8_MMA(0, 0, At, B0); PG8_BAR; PG8_SCHED;
            PG8_LDB(B1, 1, 1); PG8_STAGE(PG8_SB(1, 0), b3, voffB);
            PG8_BAR; PG8_WAIT_L(0); PG8_MMA(0, 1, At, B1); PG8_BAR;
            PG8_LDA(At, 1, 1); PG8_STAGE(PG8_SA(1, 0), a3, voffA);
            PG8_BAR; PG8_WAIT_L(0); PG8_MMA(1, 0, At, B0); PG8_BAR; PG8_SCHED;
            PG8_STAGE(PG8_SB(1, 1), b3 + bhstep, voffB);
            PG8_WAIT_V(6); PG8_BAR; PG8_MMA(1, 1, At, B1); PG8_BAR;
            }
        }
        if constexpr (F8) asm volatile("s_nop 15\n\ts_nop 7" ::: "memory");
        if constexpr (ALIGN_EPI) { if (wr == 0) PG8_BAR; }
        if constexpr (!Epi::AFTER_DRAIN) { E(acc, cur, wr, wc, fr, fq, pre); S.done(cur); }
        if (!has_next) break;
#pragma unroll
        for (int a = 0; a < 2; ++a)
#pragma unroll
            for (int b = 0; b < 2; ++b)
#pragma unroll
                for (int m = 0; m < 4; ++m)
#pragma unroll
                    for (int n = 0; n < 2; ++n) acc[a][b][m][n] = (f32x4){0.f, 0.f, 0.f, 0.f};
        cur = nxt; cA = nA; cB = nB; ++ui;
        if constexpr (ALIGN_EPI) { if (wr == 1) PG8_BAR; }
    }
    PG8_WAIT_V(0);
    if constexpr (!ALIGN_EPI) { if (wr == 0) PG8_BAR; }
    PG8_BAR;
    if constexpr (Epi::AFTER_DRAIN) { E.fused(acc, cur, wr, wc, fr, fq, lds, wid, lane); S.done(cur); }
#undef PG8_SA
#undef PG8_SB
#undef PG8_STAGE
#undef PG8_LDA
#undef PG8_LDB
#undef PG8_MMA
#undef PG8_WAIT_V
#undef PG8_WAIT_L
#undef PG8_BAR
#undef PG8_SCHED
}
}

constexpr int BATCH = 4, SEQ = 4096, D = 2048, M = BATCH * SEQ, FF = 8192, DEPTH = 4;
constexpr int AB_IN = 5136, NP_E = 5376;
constexpr int C_IN = 4176, NP_O = 4352;
constexpr int KSEL = 256;
constexpr float EPS = 1e-6f;
constexpr int EC_U = 0, EC_V = 1024, EC_Q = 2048, EC_K = 2560, EC_VV = 3072, EC_R = 4096, EC_G = 5120;
constexpr int OC_Q = 0, OC_K = 2048, OC_V = 2560, OC_IQ = 3072, OC_IK = 4096, OC_IW = 4160;

constexpr size_t MiB = 1u << 20;
constexpr size_t WS_CTL = 0, CTL_ZERO_BYTES = 2 * MiB;
constexpr size_t WS_RSS = 768 * 1024;
constexpr size_t WS_KMAX = 1920 * 1024;
constexpr size_t WS_WABIN = 2 * MiB;
constexpr size_t WS_WABOUT = WS_WABIN + 42 * MiB;
constexpr size_t WS_WCIN = WS_WABOUT + 16 * MiB;
constexpr size_t WS_WCOUT = WS_WCIN + 34 * MiB;
constexpr size_t WS_WF1 = WS_WCOUT + 16 * MiB;
constexpr size_t WS_WF2 = WS_WF1 + 128 * MiB;
constexpr size_t WS_HB = WS_WF2 + 128 * MiB;
constexpr size_t WS_AB = WS_HB + 64 * MiB;
constexpr size_t WS_P = WS_AB + 64 * MiB;
constexpr size_t WS_IDX = WS_P + 256 * MiB;
constexpr size_t WS_CNT = WS_IDX + 16 * MiB;
constexpr size_t WS_QE = WS_CNT + 1 * MiB;
constexpr size_t WS_KE = WS_QE + 16 * MiB;
constexpr size_t WS_DS = WS_KE + 16 * MiB;
constexpr size_t WS_SP = WS_DS + 32 * MiB;
constexpr size_t WS_LAST = WS_SP + 16 * MiB;
constexpr size_t WS_MASK = WS_LAST + 1 * MiB;
constexpr size_t WS_WSB = WS_MASK + 8 * MiB;
constexpr size_t WS_END = WS_WSB + 1 * MiB;
constexpr int CW_BAR = 4096;

constexpr int PH_LDS = 155648;
constexpr int LDSCTL_OFF = PH_LDS;
constexpr int LDS_BYTES = PH_LDS + 512;
constexpr int NWAVES = 8;

#define GAS __attribute__((address_space(1)))
#define LAS __attribute__((address_space(3)))
typedef unsigned short bf16;
typedef unsigned v4u __attribute__((ext_vector_type(4)));
typedef unsigned v2u __attribute__((ext_vector_type(2)));
typedef float f32x4 __attribute__((ext_vector_type(4)));
typedef __bf16 bf16x2_t __attribute__((ext_vector_type(2)));
typedef GAS unsigned gu32;
#define RLX_AGENT __ATOMIC_RELAXED, __HIP_MEMORY_SCOPE_AGENT
#define LDS_WAIT() asm volatile("s_waitcnt lgkmcnt(0)" ::: "memory")
#define VM_WAIT() asm volatile("s_waitcnt vmcnt(0)" ::: "memory")
__device__ __forceinline__ unsigned f2bf(float f) { unsigned u = __builtin_bit_cast(unsigned, f); return (u + 0x7fffu + ((u >> 16) & 1u)) >> 16; }
__device__ __forceinline__ unsigned pk2(float lo, float hi) { return f2bf(lo) | (f2bf(hi) << 16); }
__device__ __forceinline__ float bf_lo(unsigned w) { return __builtin_bit_cast(float, w << 16); }
__device__ __forceinline__ float bf_hi(unsigned w) { return __builtin_bit_cast(float, w & 0xffff0000u); }
__device__ __forceinline__ float bf2f(bf16 b) { return __builtin_bit_cast(float, ((unsigned)b) << 16); }
__device__ __forceinline__ float dot2bf(unsigned a, unsigned b, float c) { return __builtin_amdgcn_fdot2_f32_bf16(__builtin_bit_cast(bf16x2_t, a), __builtin_bit_cast(bf16x2_t, b), c, false); }
__device__ __forceinline__ float wave_sum(float v) {
#pragma unroll
    for (int o = 1; o < 64; o <<= 1) v += __shfl_xor(v, o);
    return v;
}
__device__ __forceinline__ float wave_max(float v) {
#pragma unroll
    for (int o = 1; o < 64; o <<= 1) v = fmaxf(v, __shfl_xor(v, o));
    return v;
}
__device__ __forceinline__ int half_sum_i(int v) {
    v += __builtin_amdgcn_ds_swizzle(v, 0x041F); v += __builtin_amdgcn_ds_swizzle(v, 0x081F); v += __builtin_amdgcn_ds_swizzle(v, 0x101F); v += __builtin_amdgcn_ds_swizzle(v, 0x201F); v += __builtin_amdgcn_ds_swizzle(v, 0x401F);
    return v;
}
__device__ __forceinline__ int half_sum_dpp(int v, int hh) {
    v += __builtin_amdgcn_update_dpp(0, v, 0x111, 0xf, 0xf, true);
    v += __builtin_amdgcn_update_dpp(0, v, 0x112, 0xf, 0xf, true);
    v += __builtin_amdgcn_update_dpp(0, v, 0x114, 0xf, 0xf, true);
    v += __builtin_amdgcn_update_dpp(0, v, 0x118, 0xf, 0xf, true);
    v += __builtin_amdgcn_update_dpp(0, v, 0x142, 0xa, 0xf, true);
    const int t0 = __builtin_amdgcn_readlane(v, 31), t1 = __builtin_amdgcn_readlane(v, 63);
    return hh ? t1 : t0;
}
#define WRITELANE(vreg, sval, lane_imm) asm volatile("s_nop 3\n\tv_writelane_b32 %0, %1, %2" : "+v"(vreg) : "s"(sval), "n"(lane_imm))
__device__ __forceinline__ int wave_sum_i(int v) {
#pragma unroll
    for (int o = 1; o < 64; o <<= 1) v += __shfl_xor(v, o);
    return v;
}
typedef short bf16x8 __attribute__((ext_vector_type(8)));
typedef short s16x4 __attribute__((ext_vector_type(4)));
typedef short v4i16_t __attribute__((ext_vector_type(4)));
typedef float f32x16 __attribute__((ext_vector_type(16)));
typedef float f32x2_t __attribute__((ext_vector_type(2)));
__device__ __forceinline__ unsigned cvtpk(float lo, float hi) { f32x2_t v = {lo, hi}; bf16x2_t b = __builtin_convertvector(v, bf16x2_t); return __builtin_bit_cast(unsigned, b); }
__device__ __forceinline__ s16x4 tr16(const LAS unsigned char* p) { return __builtin_bit_cast(s16x4, __builtin_amdgcn_ds_read_tr16_b64_v4i16((LAS v4i16_t*)p)); }
__device__ __forceinline__ bf16x8 ldsb128(const LAS unsigned char* p) { return *(const LAS bf16x8*)p; }
__device__ __forceinline__ bf16x8 cat8(s16x4 lo, s16x4 hi) { return __builtin_shufflevector(lo, hi, 0, 1, 2, 3, 4, 5, 6, 7); }
__device__ __forceinline__ bf16x8 pack8(const f32x16& x, int s) { v4u p; p.x = cvtpk(x[8 * s + 0], x[8 * s + 1]); p.y = cvtpk(x[8 * s + 2], x[8 * s + 3]); p.z = cvtpk(x[8 * s + 4], x[8 * s + 5]); p.w = cvtpk(x[8 * s + 6], x[8 * s + 7]); return __builtin_bit_cast(bf16x8, p); }
#define MFMA32(a, b, c) __builtin_amdgcn_mfma_f32_32x32x16_bf16((a), (b), (c), 0, 0, 0)
__device__ __forceinline__ int crow(int reg, int h) { return (reg & 3) + 8 * (reg >> 2) + 4 * h; }
__device__ const unsigned char T5B[128] = {0, 1, 2, 3, 4, 5, 6, 7, 8, 9, 10, 11, 12, 13, 14, 15, 16, 16, 16, 17, 17, 18, 18, 18, 19, 19, 19, 20, 20, 20, 20, 21, 21, 21, 21, 22, 22, 22, 22, 22, 23, 23, 23, 23, 23, 23, 24, 24, 24, 24, 24, 24, 25, 25, 25, 25, 25, 25, 25, 26, 26, 26, 26, 26, 26, 26, 26, 27, 27, 27, 27, 27, 27, 27, 27, 27, 27, 28, 28, 28, 28, 28, 28, 28, 28, 28, 28, 29, 29, 29, 29, 29, 29, 29, 29, 29, 29, 29, 29, 30, 30, 30, 30, 30, 30, 30, 30, 30, 30, 30, 30, 30, 30, 31, 31, 31, 31, 31, 31, 31, 31, 31, 31, 31, 31, 31, 31, 31};
__device__ __forceinline__ int t5_bucket(int dist) { return dist >= 128 ? 31 : (int)T5B[dist]; }

#define XB_TMO      128
#define XB_XCNT(j)  (256  + 64 * (j))
#define XB_XSUB(j)  (1280 + 64 * (j))
#define XB_XGEN(j)  (2304 + 64 * (j))
#define XB_TOP      3328
#define XB_TOPGEN   3392
#define XCD_BAR_WORDS 3456
#define XB_SPIN_CAP (1u << 18)

__device__ __forceinline__ unsigned xb_ld(unsigned* p)              { return __hip_atomic_load(p, __ATOMIC_RELAXED, __HIP_MEMORY_SCOPE_AGENT); }
__device__ __forceinline__ unsigned xb_add(unsigned* p, unsigned v) { return __hip_atomic_fetch_add(p, v, __ATOMIC_RELAXED, __HIP_MEMORY_SCOPE_AGENT); }
__device__ __forceinline__ unsigned xb_xcc_id() { return (unsigned)__builtin_amdgcn_s_getreg((3 << 11) | 20) & 0xFu; }
#define XB_SPIN(cond, bar) do { unsigned _sp = 0; while (cond) { __builtin_amdgcn_s_sleep(1); \
    if ((++_sp & 255u) == 0u) { if (xb_ld(&(bar)[XB_TMO])) break; if (_sp > XB_SPIN_CAP) { atomicAdd(&(bar)[XB_TMO], 1u); break; } } } } while (0)

struct XcdBarrier {
    unsigned* bar; unsigned x;
    volatile LAS unsigned* st;
};

__device__ __forceinline__ XcdBarrier xcd_barrier_post(unsigned* bar, volatile LAS unsigned* st) {
    XcdBarrier b; b.bar = bar; b.x = xb_xcc_id(); b.st = st;
    if (threadIdx.x == 0) (void)xb_add(&bar[XB_XCNT(b.x)], 1u);
    return b;
}
__device__ __forceinline__ void xcd_barrier_complete(unsigned* bar, unsigned x, unsigned& nloc, unsigned& nx) {
    const unsigned G = gridDim.x * gridDim.y * gridDim.z;
    unsigned sum, cnt, mine, sp = 0u;
    for (;;) {
        sum = 0u; cnt = 0u; mine = 0u;
#pragma unroll
        for (unsigned j = 0; j < 16; ++j) { const unsigned c = xb_ld(&bar[XB_XCNT(j)]); sum += c; cnt += (c > 0u) ? 1u : 0u; mine = (j == x) ? c : mine; }
        if (sum == G) break;
        __builtin_amdgcn_s_sleep(1);
        if ((++sp & 255u) == 0u) { if (xb_ld(&bar[XB_TMO])) break; if (sp > XB_SPIN_CAP) { atomicAdd(&bar[XB_TMO], 1u); break; } }
    }
    nloc = mine > 0u ? mine : 1u; nx = cnt > 0u ? cnt : 1u;
}

__device__ __forceinline__ void xcd_barrier(const XcdBarrier& b) {
    asm volatile("s_waitcnt vmcnt(0)" ::: "memory");
    __syncthreads();
    if (threadIdx.x == 0) {
        unsigned* bar = b.bar;
        __builtin_amdgcn_s_waitcnt(0);
        unsigned nloc = b.st[0], nx = b.st[1];
        if (nloc == 0u) { xcd_barrier_complete(bar, b.x, nloc, nx); b.st[0] = nloc; b.st[1] = nx; }
        const unsigned old = xb_add(&bar[XB_XSUB(b.x)], 1u);
        const unsigned gen = old / nloc;
        if (old + 1u == (gen + 1u) * nloc) {
            __builtin_amdgcn_fence(__ATOMIC_RELEASE, "agent");
            asm volatile("s_waitcnt vmcnt(0)" ::: "memory");
            const unsigned og = xb_add(&bar[XB_TOP], 1u);
            const unsigned tg = og / nx;
            if (og + 1u == (tg + 1u) * nx) xb_add(&bar[XB_TOPGEN], 1u);
            else XB_SPIN(xb_ld(&bar[XB_TOPGEN]) == tg, bar);
            __builtin_amdgcn_fence(__ATOMIC_ACQUIRE, "agent");
            xb_add(&bar[XB_XGEN(b.x)], 1u);
            asm volatile("s_waitcnt vmcnt(0)" ::: "memory");
        } else {
            XB_SPIN(xb_ld(&bar[XB_XGEN(b.x)]) == gen, bar);
            __builtin_amdgcn_fence(__ATOMIC_ACQUIRE, "agent");
            asm volatile("s_waitcnt vmcnt(0)" ::: "memory");
        }
    }
    __syncthreads();
}

struct Frame {
    LAS unsigned char* lds;
    volatile LAS unsigned* MISC;
    gu32* ctl;
    int G;
    __device__ __forceinline__ int tid_() const { int t = (int)threadIdx.x; asm volatile("" : "+v"(t)); return t; }
    __device__ __forceinline__ int lane_() const { int t = (int)threadIdx.x; asm volatile("" : "+v"(t)); return t & 63; }
    __device__ __forceinline__ int wave_() const { return __builtin_amdgcn_readfirstlane((int)threadIdx.x >> 6); }
    float* out;
    __device__ __forceinline__ const float* in(int i) const { const volatile LAS unsigned* t = MISC + 32 + 2 * i; const unsigned lo = __builtin_amdgcn_readfirstlane(t[0]), hi = __builtin_amdgcn_readfirstlane(t[1]); return (const float*)(((unsigned long long)hi << 32) | lo); }
    bf16 *Wabin, *Wabout, *Wcin, *Wcout, *Wf1, *Wf2;
    bf16 *HB, *AB, *P;
    unsigned long long* RSS;
    unsigned* KMAX;
    int *IDX, *CNT;
    bf16 *QE, *KE, *SP; float *DS, *LAST; unsigned* MASK; bf16* WSB;
};
enum { I_X = 0, I_NMG, I_NFG, I_FNG, I_ABWIN, I_AVLNG, I_AWS, I_ABS, I_BGW2, I_BGB, I_BONG, I_ABWOUT, I_CWIN, I_CWOUT, I_RELB, I_FW1, I_FW2 };

__device__ __forceinline__ void transpose_load(const float* W, int K, int N, int item, int nblk, int lane, const float* gain, f32x4 (&v)[8]) {
    const int kb = item / nblk, nb = item - kb * nblk, k0 = 64 * kb + 8 * (lane >> 3), n0 = 32 * nb + 4 * (lane & 7);
    if (n0 < N) {
#pragma unroll
        for (int i = 0; i < 8; ++i) v[i] = __builtin_nontemporal_load((const f32x4*)(W + (size_t)(k0 + i) * N + n0));
        if (gain) { const f32x4 g0 = *(const f32x4*)(gain + k0), g1 = *(const f32x4*)(gain + k0 + 4);
            v[0] = v[0] * g0.x; v[1] = v[1] * g0.y; v[2] = v[2] * g0.z; v[3] = v[3] * g0.w; v[4] = v[4] * g1.x; v[5] = v[5] * g1.y; v[6] = v[6] * g1.z; v[7] = v[7] * g1.w; }
    } else {
#pragma unroll
        for (int i = 0; i < 8; ++i) v[i] = (f32x4){0.f, 0.f, 0.f, 0.f};
    }
}
__device__ __forceinline__ void transpose_store(const f32x4 (&v)[8], int K, bf16* WT, int item, int nblk, int lane) {
    const int kb = item / nblk, nb = item - kb * nblk, k0 = 64 * kb + 8 * (lane >> 3), n0 = 32 * nb + 4 * (lane & 7);
    v4u o0, o1, o2, o3;
    o0.x = cvtpk(v[0].x, v[1].x); o0.y = cvtpk(v[2].x, v[3].x); o0.z = cvtpk(v[4].x, v[5].x); o0.w = cvtpk(v[6].x, v[7].x);
    o1.x = cvtpk(v[0].y, v[1].y); o1.y = cvtpk(v[2].y, v[3].y); o1.z = cvtpk(v[4].y, v[5].y); o1.w = cvtpk(v[6].y, v[7].y);
    o2.x = cvtpk(v[0].z, v[1].z); o2.y = cvtpk(v[2].z, v[3].z); o2.z = cvtpk(v[4].z, v[5].z); o2.w = cvtpk(v[6].z, v[7].z);
    o3.x = cvtpk(v[0].w, v[1].w); o3.y = cvtpk(v[2].w, v[3].w); o3.z = cvtpk(v[4].w, v[5].w); o3.w = cvtpk(v[6].w, v[7].w);
    bf16* op = WT + (size_t)n0 * K + k0;
    *(v4u*)op = o0; *(v4u*)(op + K) = o1; *(v4u*)(op + 2 * (size_t)K) = o2; *(v4u*)(op + 3 * (size_t)K) = o3;
}
__device__ __forceinline__ void transpose_store_f8(const f32x4 (&v)[8], int K, unsigned char* WT8, int item, int nblk, int lane, float scale) {
    const int kb = item / nblk, nb = item - kb * nblk, k0 = 64 * kb + 8 * (lane >> 3), n0 = 32 * nb + 4 * (lane & 7);
    f32x4 s[8];
#pragma unroll
    for (int i = 0; i < 8; ++i) { s[i] = v[i] * scale;
#pragma unroll
        for (int j = 0; j < 4; ++j) s[i][j] = fminf(fmaxf(s[i][j], -pg8::F8_MAX), pg8::F8_MAX); }
    v2u o0, o1, o2, o3;
    o0.x = pg8::pk4_fp8(s[0].x, s[1].x, s[2].x, s[3].x); o0.y = pg8::pk4_fp8(s[4].x, s[5].x, s[6].x, s[7].x);
    o1.x = pg8::pk4_fp8(s[0].y, s[1].y, s[2].y, s[3].y); o1.y = pg8::pk4_fp8(s[4].y, s[5].y, s[6].y, s[7].y);
    o2.x = pg8::pk4_fp8(s[0].z, s[1].z, s[2].z, s[3].z); o2.y = pg8::pk4_fp8(s[4].z, s[5].z, s[6].z, s[7].z);
    o3.x = pg8::pk4_fp8(s[0].w, s[1].w, s[2].w, s[3].w); o3.y = pg8::pk4_fp8(s[4].w, s[5].w, s[6].w, s[7].w);
    unsigned char* op = WT8 + (size_t)n0 * K + k0;
    *(v2u*)op = o0; *(v2u*)(op + K) = o1; *(v2u*)(op + 2 * (size_t)K) = o2; *(v2u*)(op + 3 * (size_t)K) = o3;
}
#ifndef CONV_DEPTH
#define CONV_DEPTH 4
#endif
#define CONV_LOOP(lo_, hi_, LD, ST) do { \
    _Pragma("unroll 1") for (int it_ = (lo_) + gw; it_ < (hi_); it_ += CONV_DEPTH * NGW) { \
        f32x4 v_[CONV_DEPTH][8]; \
        _Pragma("unroll") for (int j_ = 0; j_ < CONV_DEPTH; ++j_) { const int i2 = it_ + j_ * NGW; if (i2 < (hi_)) { LD(i2, v_[j_]); } } \
        _Pragma("unroll") for (int j_ = 0; j_ < CONV_DEPTH; ++j_) { const int i2 = it_ + j_ * NGW; if (i2 < (hi_)) { ST(i2, v_[j_]); } } \
    } } while (0)
__device__ __forceinline__ bool conv_slot(Frame& F, int part, int& gw, int& ngw) {
    if (part < 0) { gw = blockIdx.x * NWAVES + F.wave_(); ngw = F.G * NWAVES; return true; }
    const int b = (int)blockIdx.x;
    if ((F.G & 15) != 0) { if (part == 0) { gw = b * NWAVES + F.wave_(); ngw = F.G * NWAVES; return true; } return false; }
    if (((b >> 3) & 1) != part) return false;
    gw = (((b >> 4) << 3) | (b & 7)) * NWAVES + F.wave_(); ngw = (F.G >> 1) * NWAVES; return true;
}
__device__ __forceinline__ void convert_inout(Frame& F, int L, int part = -1) {
    int gw, NGW; if (!conv_slot(F, part, gw, NGW)) return;
    const bool all = part < 0 || (F.G & 15) != 0;
    const int lane = F.lane_(), l = L >> 1;
    constexpr int I_ABIN = (D / 64) * (NP_E / 32), I_SQ = (D / 64) * (D / 32), I_CIN = (D / 64) * (NP_O / 32);
    if (!(L & 1)) {
        const int n = I_ABIN + I_SQ, lo = all ? 0 : (part ? n / 2 : 0), hi = all ? n : (part ? n : n / 2);
#define LD_(i2, v) do { if (i2 < I_ABIN) transpose_load(F.in(I_ABWIN) + (size_t)l * D * AB_IN, D, AB_IN, i2, NP_E / 32, lane, F.in(I_NMG) + (size_t)L * D, v); else transpose_load(F.in(I_ABWOUT) + (size_t)l * D * D, D, D, i2 - I_ABIN, D / 32, lane, nullptr, v); } while (0)
#define ST_(i2, v) do { if (i2 < I_ABIN) transpose_store(v, D, F.Wabin + (size_t)l * NP_E * D, i2, NP_E / 32, lane); else transpose_store(v, D, F.Wabout + (size_t)l * D * D, i2 - I_ABIN, D / 32, lane); } while (0)
        CONV_LOOP(lo, hi, LD_, ST_);
#undef LD_
#undef ST_
    } else {
        const int n = I_CIN + I_SQ, lo = all ? 0 : (part ? n / 2 : 0), hi = all ? n : (part ? n : n / 2);
#define LD_(i2, v) do { if (i2 < I_CIN) transpose_load(F.in(I_CWIN) + (size_t)l * D * C_IN, D, C_IN, i2, NP_O / 32, lane, F.in(I_NMG) + (size_t)L * D, v); else transpose_load(F.in(I_CWOUT) + (size_t)l * D * D, D, D, i2 - I_CIN, D / 32, lane, nullptr, v); } while (0)
#define ST_(i2, v) do { if (i2 < I_CIN) transpose_store(v, D, F.Wcin + (size_t)l * NP_O * D, i2, NP_O / 32, lane); else transpose_store(v, D, F.Wcout + (size_t)l * D * D, i2 - I_CIN, D / 32, lane); } while (0)
        CONV_LOOP(lo, hi, LD_, ST_);
#undef LD_
#undef ST_
    }
}
constexpr float W2_F8_SCALE = 1024.f;
constexpr float W1_F8_SCALE = 512.f;
__device__ __forceinline__ void convert_ffn(Frame& F, int L, int part = -1, bool w2_f8 = false, bool w1_f8 = false) {
    int gw, NGW; if (!conv_slot(F, part, gw, NGW)) return;
    const bool all = part < 0 || (F.G & 15) != 0;
    const int lane = F.lane_();
    constexpr int I_F = (D / 64) * (FF / 32);
    const int lo = all ? 0 : (part ? I_F : 0), hi = all ? 2 * I_F : (part ? 2 * I_F : I_F);
#define LD_(i2, v) do { if (i2 < I_F) transpose_load(F.in(I_FW1) + (size_t)L * D * FF, D, FF, i2, FF / 32, lane, F.in(I_NFG) + (size_t)L * D, v); else transpose_load(F.in(I_FW2) + (size_t)L * FF * D, FF, D, i2 - I_F, D / 32, lane, nullptr, v); } while (0)
#define ST_(i2, v) do { if (i2 < I_F) { if (w1_f8) transpose_store_f8(v, D, (unsigned char*)(F.Wf1 + (size_t)L * FF * D), i2, FF / 32, lane, W1_F8_SCALE); else transpose_store(v, D, F.Wf1 + (size_t)L * FF * D, i2, FF / 32, lane); } else if (w2_f8) transpose_store_f8(v, FF, (unsigned char*)(F.Wf2 + (size_t)L * D * FF), i2 - I_F, D / 32, lane, W2_F8_SCALE); else transpose_store(v, FF, F.Wf2 + (size_t)L * D * FF, i2 - I_F, D / 32, lane); } while (0)
    CONV_LOOP(lo, hi, LD_, ST_);
#undef LD_
#undef ST_
}
#ifndef JIT_WEIGHTS
#define JIT_WEIGHTS 1
#endif
__device__ __forceinline__ void p0_prologue(Frame& F) {
    const int gw = blockIdx.x * NWAVES + F.wave_(), NGW = F.G * NWAVES, lane = F.lane_();
    { const float* ws_ = F.in(I_AWS);
      for (int i = (int)blockIdx.x * 512 + F.tid_(); i < 2 * 8 * 128 * 128; i += F.G * 512) { const int s = i & 127, t = (i >> 7) & 127; F.WSB[i] = (bf16)((s <= t) ? f2bf(ws_[i]) : 0u); } }
#if JIT_WEIGHTS
    convert_inout(F, 0);
#else
#pragma unroll 1
    for (int L = 0; L < DEPTH; ++L) { convert_inout(F, L); convert_ffn(F, L); }
#endif
    { const float* x = F.in(I_X);
      for (int m = gw; m < M; m += NGW) {
          const f32x4* xr = (const f32x4*)(x + (size_t)m * D) + lane; float ss = 0.f;
#pragma unroll
          for (int jj = 0; jj < 8; ++jj) { const f32x4 v = xr[64 * jj]; ss += (v.x * v.x + v.y * v.y) + (v.z * v.z + v.w * v.w); v2u wv; wv.x = cvtpk(v.x, v.y); wv.y = cvtpk(v.z, v.w); ((v2u*)(F.HB + (size_t)m * D))[lane + 64 * jj] = wv; }
          ss = wave_sum(ss);
          if (lane == 0) F.RSS[m] = (unsigned long long)(ss * 65536.f + 0.5f);
      } }
}

__device__ __forceinline__ void final_norm_phase(Frame& F, const float* g, const unsigned long long* rss, const bf16* hb, float* out) {
    const int gw = blockIdx.x * NWAVES + F.wave_(), NGW = F.G * NWAVES, lane = F.lane_();
    for (int m = gw; m < M; m += NGW) {
        const float rstd = rsqrtf((float)rss[m] * (1.f / (65536.f * 2048.f)) + EPS);
        const v4u* hr = (const v4u*)(hb + (size_t)m * D) + lane; f32x4* orow = (f32x4*)(out + (size_t)m * D);
#pragma unroll
        for (int j = 0; j < 4; ++j) { const v4u w = hr[64 * j]; const f32x4 g0 = ((const f32x4*)g)[2 * (lane + 64 * j)], g1 = ((const f32x4*)g)[2 * (lane + 64 * j) + 1];
            const f32x4 a = {bf_lo(w.x) * rstd * g0.x, bf_hi(w.x) * rstd * g0.y, bf_lo(w.y) * rstd * g0.z, bf_hi(w.y) * rstd * g0.w};
            const f32x4 c = {bf_lo(w.z) * rstd * g1.x, bf_hi(w.z) * rstd * g1.y, bf_lo(w.w) * rstd * g1.z, bf_hi(w.w) * rstd * g1.w};
            orow[2 * (lane + 64 * j)] = a; orow[2 * (lane + 64 * j) + 1] = c; }
    }
}

__device__ __forceinline__ void gla_a_unit(Frame& F, int li, int u) {
    const int c = u & 15, h = (u >> 4) & 3, b = u >> 6, t0 = b * SEQ + c * 256;
    const int tid = F.tid_(), lane = F.lane_(), w = F.wave_();
    LAS float* GL = (LAS float*)F.lds;
    LAS float* QT = (LAS float*)(F.lds + 16384);
    LAS unsigned char* KST = F.lds + 18432;
    LAS unsigned char* VIM = F.lds + 18432 + 67584;
    const bf16* Pr = F.P + (size_t)t0 * NP_E;
    { const int row = tid >> 1, hf = tid & 1; const v4u g = *(const v4u*)(Pr + (size_t)row * NP_E + EC_G + 8 * hf);
      const f32x4 a = {bf_lo(g.x), bf_hi(g.x), bf_lo(g.y), bf_hi(g.y)}, a2 = {bf_lo(g.z), bf_hi(g.z), bf_lo(g.w), bf_hi(g.w)};
      *(LAS f32x4*)(GL + row * 16 + 8 * hf) = a; *(LAS f32x4*)(GL + row * 16 + 8 * hf + 4) = a2; }
    const int d = tid & 127, qtr = __builtin_amdgcn_readfirstlane(tid >> 7);
    float gw[16];
    { const float* gw2 = F.in(I_BGW2) + (size_t)li * 16 * 512 + h * 128 + d;
#pragma unroll
      for (int r = 0; r < 16; ++r) gw[r] = gw2[r * 512]; }
    const float gbd = F.in(I_BGB)[(size_t)li * 512 + h * 128 + d];
    v4u vst[4];
#pragma unroll
    for (int i = 0; i < 4; ++i) { const int piece = tid + 512 * i, row = piece >> 5, pc = piece & 31; vst[i] = *(const v4u*)(Pr + (size_t)row * NP_E + EC_VV + h * 256 + pc * 8); }
    __syncthreads();
    float cl[64]; float run = 0.f;
#pragma unroll
    for (int jj = 0; jj < 64; ++jj) {
        const LAS f32x4* g4 = (const LAS f32x4*)(GL + (qtr * 64 + jj) * 16); const f32x4 g0 = g4[0], g1 = g4[1], g2 = g4[2], g3 = g4[3];
        float x = gbd;
        x += g0.x * gw[0]; x += g0.y * gw[1]; x += g0.z * gw[2]; x += g0.w * gw[3]; x += g1.x * gw[4]; x += g1.y * gw[5]; x += g1.z * gw[6]; x += g1.w * gw[7];
        x += g2.x * gw[8]; x += g2.y * gw[9]; x += g2.z * gw[10]; x += g2.w * gw[11]; x += g3.x * gw[12]; x += g3.y * gw[13]; x += g3.z * gw[14]; x += g3.w * gw[15];
        const float ls = fminf(x, 0.f) - __logf(1.f + __expf(-fabsf(x)));
        run += ls * (1.f / 16.f); cl[jj] = run;
    }
    QT[qtr * 128 + d] = run;
    __syncthreads();
    float pre = 0.f, last = 0.f;
#pragma unroll
    for (int q = 0; q < 4; ++q) { const float tq = QT[q * 128 + d]; pre += (q < qtr) ? tq : 0.f; last += tq; }
    const float ref = 0.5f * last, eref = __expf(ref);
    if (qtr == 0) F.LAST[(size_t)u * 128 + d] = last;
    {
        const bf16* qp = Pr + (size_t)(qtr * 64) * NP_E + EC_Q + h * 128 + d; const bf16* kp = Pr + (size_t)(qtr * 64) * NP_E + EC_K + h * 128 + d;
        bf16* qo = F.QE + (size_t)(t0 + qtr * 64) * 512 + h * 128 + d; bf16* ko = F.KE + (size_t)(t0 + qtr * 64) * 512 + h * 128 + d;
#pragma unroll
        for (int j8 = 0; j8 < 8; ++j8) {
            float ks[8];
#pragma unroll
            for (int e = 0; e < 8; ++e) { const int jj = j8 * 8 + e;
                const float e1 = __expf(cl[jj] + pre - ref), e2 = __builtin_amdgcn_rcpf(e1);
                const float qv = bf2f(qp[(size_t)jj * NP_E]), kv = bf2f(kp[(size_t)jj * NP_E]);
                const float ke = kv * e2;
                qo[(size_t)jj * 512] = (bf16)f2bf(qv * 0.08838834764831845f * e1); ko[(size_t)jj * 512] = (bf16)f2bf(ke); ks[e] = ke * eref; }
            v4u pk; pk.x = cvtpk(ks[0], ks[1]); pk.y = cvtpk(ks[2], ks[3]); pk.z = cvtpk(ks[4], ks[5]); pk.w = cvtpk(ks[6], ks[7]);
            *(LAS v4u*)(KST + d * 528 + (qtr * 64 + j8 * 8) * 2) = pk;
        }
    }
    const int vq = w >> 1, dh = w & 1, r = lane & 31, hh = lane >> 5, blk = (lane >> 4) & 1, q4 = (lane >> 2) & 3, p4 = lane & 3;
    f32x16 acc[2][2];
#pragma unroll
    for (int a = 0; a < 2; ++a)
#pragma unroll
        for (int e = 0; e < 2; ++e)
#pragma unroll
            for (int i = 0; i < 16; ++i) acc[a][e][i] = 0.f;
#pragma unroll 1
    for (int jb = 0; jb < 4; ++jb) {
#pragma unroll
        for (int i = 0; i < 4; ++i) { const int piece = tid + 512 * i, row = piece >> 5, pc = piece & 31;
            *(LAS v4u*)(VIM + row * 576 + pc * 16) = vst[i]; }
        if (jb < 3) {
#pragma unroll
            for (int i = 0; i < 4; ++i) { const int piece = tid + 512 * i, row = piece >> 5, pc = piece & 31; vst[i] = *(const v4u*)(Pr + (size_t)(64 * (jb + 1) + row) * NP_E + EC_VV + h * 256 + pc * 8); }
        }
        __syncthreads();
#pragma unroll
        for (int ks = 0; ks < 4; ++ks) {
            bf16x8 A[2], B[2];
#pragma unroll
            for (int vt = 0; vt < 2; ++vt) { const LAS unsigned char* pa = VIM + (16 * ks + 8 * hh + q4) * 576 + (64 * vq + 32 * vt + 16 * blk + 4 * p4) * 2;
                A[vt] = cat8(tr16(pa), tr16(pa + 4 * 576)); }
#pragma unroll
            for (int dt = 0; dt < 2; ++dt) B[dt] = ldsb128(KST + (64 * dh + 32 * dt + r) * 528 + (64 * jb + 16 * ks + 8 * hh) * 2);
#pragma unroll
            for (int vt = 0; vt < 2; ++vt)
#pragma unroll
                for (int dt = 0; dt < 2; ++dt) acc[vt][dt] = MFMA32(A[vt], B[dt], acc[vt][dt]);
        }
        __syncthreads();
    }
    float* dso = F.DS + (size_t)u * 32768;
#pragma unroll
    for (int vt = 0; vt < 2; ++vt)
#pragma unroll
        for (int dt = 0; dt < 2; ++dt)
#pragma unroll
            for (int reg = 0; reg < 16; ++reg) dso[(size_t)(64 * vq + 32 * vt + crow(reg, hh)) * 128 + 64 * dh + 32 * dt + r] = acc[vt][dt][reg];
}
__device__ __forceinline__ void gla_scan(Frame& F) {
    for (int gt = (int)blockIdx.x * 512 + F.tid_(); gt < 131072; gt += F.G * 512) {
        const int bh = gt >> 13, e4 = gt & 8191, d4 = (e4 & 31) * 4;
        f32x4 S = {0.f, 0.f, 0.f, 0.f};
#pragma unroll 4
        for (int c = 0; c < 16; ++c) {
            const int u = bh * 16 + c;
            const f32x4 last = *(const f32x4*)(F.LAST + (size_t)u * 128 + d4);
            const f32x4 er = {__expf(0.5f * last.x), __expf(0.5f * last.y), __expf(0.5f * last.z), __expf(0.5f * last.w)};
            v2u o; o.x = cvtpk(S.x * er.x, S.y * er.y); o.y = cvtpk(S.z * er.z, S.w * er.w);
            *(v2u*)(F.SP + (size_t)u * 32768 + (size_t)e4 * 4) = o;
            if (c < 15) { const f32x4 ds = *(const f32x4*)(F.DS + (size_t)u * 32768 + (size_t)e4 * 4);
                S.x = er.x * er.x * S.x + ds.x; S.y = er.y * er.y * S.y + ds.y; S.z = er.z * er.z * S.z + ds.z; S.w = er.w * er.w * S.w + ds.w; }
        }
    }
}
__device__ __forceinline__ void gla_c_unit(Frame& F, int li, int u) {
    const int c = u & 15, h = (u >> 4) & 3, b = u >> 6, t0 = b * SEQ + c * 256;
    const int tid = F.tid_(), lane = F.lane_(), w = F.wave_();
    const int r = lane & 31, hh = lane >> 5, blk = (lane >> 4) & 1, q4 = (lane >> 2) & 3, p4 = lane & 3, i0 = 32 * w;
    LAS unsigned char* SIM = F.lds;
    LAS unsigned char* KIM = F.lds;
    LAS unsigned char* VIM = F.lds + 17408;
    bf16x8 qf[8];
    { const bf16* qrow = F.QE + (size_t)(t0 + i0 + r) * 512 + h * 128 + 8 * hh;
#pragma unroll
      for (int ks = 0; ks < 8; ++ks) qf[ks] = *(const bf16x8*)(qrow + 16 * ks); }
    { const bf16* sp = F.SP + (size_t)u * 32768;
#pragma unroll
      for (int i = 0; i < 8; ++i) { const int piece = tid + 512 * i, row = piece >> 4, pc = piece & 15; *(LAS v4u*)(SIM + row * 272 + pc * 16) = *(const v4u*)(sp + row * 128 + pc * 8); } }
    __syncthreads();
    f32x16 acc[8];
#pragma unroll
    for (int vt = 0; vt < 8; ++vt)
#pragma unroll
        for (int i = 0; i < 16; ++i) acc[vt][i] = 0.f;
#pragma unroll
    for (int vt = 0; vt < 8; ++vt)
#pragma unroll
        for (int ks = 0; ks < 8; ++ks) acc[vt] = MFMA32(ldsb128(SIM + (32 * vt + r) * 272 + (16 * ks + 8 * hh) * 2), qf[ks], acc[vt]);
    __syncthreads();
#pragma unroll 1
    for (int jb = 0; jb < 4; ++jb) {
#pragma unroll
        for (int i = 0; i < 2; ++i) { const int piece = tid + 512 * i, row = piece >> 4, pc = piece & 15;
            *(LAS v4u*)(KIM + row * 272 + pc * 16) = *(const v4u*)(F.KE + (size_t)(t0 + 64 * jb + row) * 512 + h * 128 + pc * 8); }
#pragma unroll
        for (int i = 0; i < 4; ++i) { const int piece = tid + 512 * i, row = piece >> 5, pc = piece & 31;
            *(LAS v4u*)(VIM + row * 576 + pc * 16) = *(const v4u*)(F.P + (size_t)(t0 + 64 * jb + row) * NP_E + EC_VV + h * 256 + pc * 8); }
        __syncthreads();
#pragma unroll 1
        for (int jt = 0; jt < 2; ++jt) {
            const int j0 = 64 * jb + 32 * jt;
            if (j0 <= i0 + 31) {
                f32x16 X;
#pragma unroll
                for (int i = 0; i < 16; ++i) X[i] = 0.f;
#pragma unroll
                for (int ks = 0; ks < 8; ++ks) X = MFMA32(ldsb128(KIM + (32 * jt + r) * 272 + (16 * ks + 8 * hh) * 2), qf[ks], X);
                if (j0 + 31 > i0) {
#pragma unroll
                    for (int reg = 0; reg < 16; ++reg) X[reg] = (j0 + crow(reg, hh) > i0 + r) ? 0.f : X[reg];
                }
                const bf16x8 xs0 = pack8(X, 0), xs1 = pack8(X, 1);
#pragma unroll
                for (int vt = 0; vt < 8; ++vt) {
                    const LAS unsigned char* pa = VIM + (32 * jt + 4 * hh + q4) * 576 + (32 * vt + 16 * blk + 4 * p4) * 2;
                    acc[vt] = MFMA32(cat8(tr16(pa), tr16(pa + 8 * 576)), xs0, acc[vt]);
                    acc[vt] = MFMA32(cat8(tr16(pa + 16 * 576), tr16(pa + 24 * 576)), xs1, acc[vt]);
                }
            }
        }
        __syncthreads();
    }
    float ss = 0.f;
#pragma unroll
    for (int vt = 0; vt < 8; ++vt)
#pragma unroll
        for (int i = 0; i < 16; ++i) ss += acc[vt][i] * acc[vt][i];
    ss += __shfl_xor(ss, 32);
    const float rn = 1.f / sqrtf(ss * (1.f / 256.f) + EPS);
    const float* ong = F.in(I_BONG) + (size_t)li * 256;
    const bf16* rrow = F.P + (size_t)(t0 + i0 + r) * NP_E + EC_R + h * 256;
    bf16* orow = F.AB + (size_t)(t0 + i0 + r) * D + 1024 + h * 256;
#pragma unroll
    for (int vt = 0; vt < 8; ++vt)
#pragma unroll
        for (int g4 = 0; g4 < 4; ++g4) {
            const int v0 = 32 * vt + 8 * g4 + 4 * hh;
            const v2u rr = *(const v2u*)(rrow + v0); const f32x4 gg = *(const f32x4*)(ong + v0);
            const float r0 = bf_lo(rr.x), r1 = bf_hi(rr.x), r2 = bf_lo(rr.y), r3 = bf_hi(rr.y);
            const float o0 = acc[vt][4 * g4 + 0] * rn * gg.x * (r0 / (1.f + __expf(-r0))), o1 = acc[vt][4 * g4 + 1] * rn * gg.y * (r1 / (1.f + __expf(-r1)));
            const float o2 = acc[vt][4 * g4 + 2] * rn * gg.z * (r2 / (1.f + __expf(-r2))), o3 = acc[vt][4 * g4 + 3] * rn * gg.w * (r3 / (1.f + __expf(-r3)));
            v2u o; o.x = cvtpk(o0, o1); o.y = cvtpk(o2, o3);
            *(v2u*)(orow + v0) = o;
        }
}

__device__ __forceinline__ void sgu2_unit(Frame& F, int li, int u) {
    const int b = u >> 8, n = (u >> 3) & 31, g = u & 7, m0 = b * SEQ + n * 128;
    const int tid = F.tid_(), lane = F.lane_(), w = F.wave_(), r = lane & 31, hh = lane >> 5, blk = (lane >> 4) & 1, q4 = (lane >> 2) & 3, p4 = lane & 3;
    LAS unsigned char* VIM = F.lds;
    const int ct = w & 3, tp = w >> 2;
    const bf16* Wb = F.WSB + (size_t)(li * 8 + g) * 128 * 128;
    bf16x8 af[2][8]; unsigned short uu[2][16];
#pragma unroll
    for (int half = 0; half < 2; ++half) { const int tt = half ? 3 - tp : tp; const bf16* arow = Wb + (size_t)(32 * tt + r) * 128 + 8 * hh;
#pragma unroll
        for (int ks = 0; ks < 8; ++ks) af[half][ks] = *(const bf16x8*)(arow + 16 * ks);
#pragma unroll
        for (int reg = 0; reg < 16; ++reg) uu[half][reg] = F.P[(size_t)(m0 + 32 * tt + crow(reg, hh)) * NP_E + EC_U + 128 * g + 32 * ct + r]; }
    {
        const int s = tid >> 2, q = tid & 3;
        const v4u* row = (const v4u*)(F.P + (size_t)(m0 + s) * NP_E + EC_V + 128 * g + 32 * q);
        float x[32];
#pragma unroll
        for (int i = 0; i < 4; ++i) { const v4u wv = row[i]; x[8 * i + 0] = bf_lo(wv.x); x[8 * i + 1] = bf_hi(wv.x); x[8 * i + 2] = bf_lo(wv.y); x[8 * i + 3] = bf_hi(wv.y); x[8 * i + 4] = bf_lo(wv.z); x[8 * i + 5] = bf_hi(wv.z); x[8 * i + 6] = bf_lo(wv.w); x[8 * i + 7] = bf_hi(wv.w); }
        float sm = 0.f;
#pragma unroll
        for (int i = 0; i < 32; ++i) sm += x[i];
        sm += __shfl_xor(sm, 1); sm += __shfl_xor(sm, 2);
        const float mu = sm * (1.f / 128.f); float q2 = 0.f;
#pragma unroll
        for (int i = 0; i < 32; ++i) { x[i] -= mu; q2 += x[i] * x[i]; }
        q2 += __shfl_xor(q2, 1); q2 += __shfl_xor(q2, 2);
        const float rstd = 1.f / sqrtf(q2 * (1.f / 128.f) + EPS);
        const f32x4* lg = (const f32x4*)(F.in(I_AVLNG) + (size_t)(li * 8 + g) * 128 + 32 * q);
#pragma unroll
        for (int i = 0; i < 4; ++i) { const f32x4 g0 = lg[2 * i], g1 = lg[2 * i + 1]; v4u o;
            o.x = cvtpk(x[8 * i + 0] * rstd * g0.x, x[8 * i + 1] * rstd * g0.y); o.y = cvtpk(x[8 * i + 2] * rstd * g0.z, x[8 * i + 3] * rstd * g0.w);
            o.z = cvtpk(x[8 * i + 4] * rstd * g1.x, x[8 * i + 5] * rstd * g1.y); o.w = cvtpk(x[8 * i + 6] * rstd * g1.z, x[8 * i + 7] * rstd * g1.w);
            *(LAS v4u*)(VIM + s * 320 + (32 * q + 8 * i) * 2) = o; }
    }
    __syncthreads();
    const float* bbase = F.in(I_ABS) + (size_t)(li * 8 + g) * 128;
#pragma unroll
    for (int half = 0; half < 2; ++half) {
        const int tt = half ? 3 - tp : tp;
        f32x16 acc;
#pragma unroll
        for (int i = 0; i < 16; ++i) acc[i] = 0.f;
#pragma unroll
        for (int ks = 0; ks < 8; ++ks) {
            if (ks < 2 * (tt + 1)) {
                const LAS unsigned char* pb = VIM + (16 * ks + 8 * hh + q4) * 320 + (32 * ct + 16 * blk + 4 * p4) * 2;
                acc = MFMA32(af[half][ks], cat8(tr16(pb), tr16(pb + 4 * 320)), acc);
            }
        }
        const int c = 32 * ct + r;
#pragma unroll
        for (int reg = 0; reg < 16; ++reg) { const int t = 32 * tt + crow(reg, hh);
            F.AB[(size_t)(m0 + t) * D + 128 * g + c] = (bf16)f2bf(bf2f(uu[half][reg]) * (acc[reg] + bbase[t])); }
    }
    __syncthreads();
}

template <int NT> __device__ __forceinline__ void inproj_tail(Frame& F, const bf16* Wt  , const unsigned long long* rss, bf16* Pout  , int ldc) {
    typedef float f32x4v __attribute__((ext_vector_type(4)));
    const int lane = F.lane_(), w = F.wave_(), kq = w & 3, rh = w >> 2, l15 = lane & 15, kg = lane >> 4;
    LAS float* red = (LAS float*)F.lds;
    for (int rb = (int)blockIdx.x; rb < M / 64; rb += F.G) {
        const int m0 = rb * 64 + rh * 32;
        f32x4v acc[2][NT];
#pragma unroll
        for (int t = 0; t < 2; ++t)
#pragma unroll
            for (int ct = 0; ct < NT; ++ct) acc[t][ct] = (f32x4v){0.f, 0.f, 0.f, 0.f};
        const bf16* ap = F.HB + (size_t)(m0 + l15) * D + kq * 512 + 8 * kg;
        const bf16* bp = Wt + (size_t)l15 * D + kq * 512 + 8 * kg;
#pragma unroll 1
        for (int kk = 0; kk < 4; ++kk) {
            bf16x8 a[2][4], bfr[NT][4];
#pragma unroll
            for (int s = 0; s < 4; ++s) {
#pragma unroll
                for (int t = 0; t < 2; ++t) a[t][s] = *(const bf16x8*)(ap + (size_t)(16 * t) * D + 128 * kk + 32 * s);
#pragma unroll
                for (int ct = 0; ct < NT; ++ct) bfr[ct][s] = *(const bf16x8*)(bp + (size_t)(16 * ct) * D + 128 * kk + 32 * s);
            }
#pragma unroll
            for (int s = 0; s < 4; ++s)
#pragma unroll
                for (int t = 0; t < 2; ++t)
#pragma unroll
                    for (int ct = 0; ct < NT; ++ct) acc[t][ct] = __builtin_amdgcn_mfma_f32_16x16x32_bf16(a[t][s], bfr[ct][s], acc[t][ct], 0, 0, 0);
        }
        if (kq != 0) {
#pragma unroll
            for (int t = 0; t < 2; ++t)
#pragma unroll
                for (int ct = 0; ct < NT; ++ct) *(LAS f32x4v*)(red + (((((kq - 1) * 2 + rh) * 2 + t) * NT + ct) * 64 + lane) * 4) = acc[t][ct];
        }
        __syncthreads();
        if (kq == 0) {
#pragma unroll
            for (int t = 0; t < 2; ++t) {
                float rs[4];
#pragma unroll
                for (int i = 0; i < 4; ++i) rs[i] = rsqrtf((float)rss[m0 + 16 * t + 4 * kg + i] * (1.f / (65536.f * 2048.f)) + EPS);
#pragma unroll
                for (int ct = 0; ct < NT; ++ct) {
                    f32x4v o = acc[t][ct];
#pragma unroll
                    for (int q = 0; q < 3; ++q) o += *(const LAS f32x4v*)(red + ((((q * 2 + rh) * 2 + t) * NT + ct) * 64 + lane) * 4);
#pragma unroll
                    for (int i = 0; i < 4; ++i) Pout[(size_t)(m0 + 16 * t + 4 * kg + i) * ldc + 16 * ct + l15] = (bf16)f2bf(o[i] * rs[i]);
                }
            }
        }
        __syncthreads();
    }
}

#ifndef IDX_ASM_FMA
#define IDX_ASM_FMA 1
#endif
__device__ __forceinline__ unsigned f2key(float f) { const unsigned u = __builtin_bit_cast(unsigned, f); return u ^ ((unsigned)((int)u >> 31) | 0x80000000u); }
__device__ __forceinline__ void idx2_unit(Frame& F, int li, int u, const bool sel = true) {
    const int m0 = 16 * u, b = m0 / SEQ, tq0 = m0 % SEQ, tmax = tq0 + 15, nblk = (tmax >> 7) + 1;
    const int tid = F.tid_(), lane = F.lane_(), w = F.wave_(), r = lane & 31, hh = lane >> 5;
    const int tq = tq0 + 2 * w + hh;
    const int vlim = tq - r;
    const bf16* Pb = F.P + (size_t)b * SEQ * NP_O;
    LAS unsigned char* KB = F.lds;
    {
        const bf16* kr = F.P + (size_t)(m0 + 2 * w + (lane >> 5)) * NP_O + OC_K + ((lane >> 3) & 3) * 128 + (lane & 7) * 16;
        const v4u k0 = *(const v4u*)kr, k1 = *(const v4u*)(kr + 8);
        float s = dot2bf(k0.x, k0.x, 0.f); s = dot2bf(k0.y, k0.y, s); s = dot2bf(k0.z, k0.z, s); s = dot2bf(k0.w, k0.w, s);
        s = dot2bf(k1.x, k1.x, s); s = dot2bf(k1.y, k1.y, s); s = dot2bf(k1.z, k1.z, s); s = dot2bf(k1.w, k1.w, s);
        s += __shfl_xor(s, 1); s += __shfl_xor(s, 2); s += __shfl_xor(s, 4);
        s = fmaxf(s, __shfl_xor(s, 32));
        if (lane < 32 && (lane & 7) == 0) atomicMax(F.KMAX + li * 16 + b * 4 + (lane >> 3), __builtin_bit_cast(unsigned, s));
    }
    bf16x8 af[4];
    { const int qq = (r >> 2) & 1, hd = ((r >> 3) << 2) | (r & 3);
      const bf16* arow = F.P + (size_t)(m0 + 2 * w + qq) * NP_O + OC_IQ + hd * 64 + 8 * hh;
#pragma unroll
      for (int ks = 0; ks < 4; ++ks) af[ks] = *(const bf16x8*)(arow + 16 * ks); }
    float wv[16];
    { const bf16* wrow = F.P + (size_t)(m0 + 2 * w + hh) * NP_O + OC_IW; const v4u a = *(const v4u*)wrow, c = *(const v4u*)(wrow + 8);
      wv[0] = bf_lo(a.x); wv[1] = bf_hi(a.x); wv[2] = bf_lo(a.y); wv[3] = bf_hi(a.y); wv[4] = bf_lo(a.z); wv[5] = bf_hi(a.z); wv[6] = bf_lo(a.w); wv[7] = bf_hi(a.w);
      wv[8] = bf_lo(c.x); wv[9] = bf_hi(c.x); wv[10] = bf_lo(c.y); wv[11] = bf_hi(c.y); wv[12] = bf_lo(c.z); wv[13] = bf_hi(c.z); wv[14] = bf_lo(c.w); wv[15] = bf_hi(c.w); }
    unsigned key[128];
#pragma unroll
    for (int k = 0; k < 128; ++k) key[k] = 0u;
    v4u st[2];
    const int srow = tid >> 3, spc = tid & 7;
    const bf16* sbase = Pb + (size_t)srow * NP_O + OC_IK + spc * 8;
#pragma unroll
    for (int i = 0; i < 2; ++i) st[i] = *(const v4u*)(sbase + (size_t)(64 * i) * NP_O);
#pragma unroll
    for (int blk = 0; blk < 32; ++blk) {
        if (blk < nblk) {
            LAS unsigned char* kb = KB + (blk & 1) * 18432;
#pragma unroll
            for (int i = 0; i < 2; ++i) *(LAS v4u*)(kb + (srow + 64 * i) * 144 + spc * 16) = st[i];
            if (blk + 1 < nblk) {
#pragma unroll
                for (int i = 0; i < 2; ++i) st[i] = *(const v4u*)(sbase + (size_t)(128 * (blk + 1) + 64 * i) * NP_O);
            }
            __syncthreads();
            bf16x8 bq[4];
#pragma unroll
            for (int ks = 0; ks < 4; ++ks) bq[ks] = ldsb128(kb + r * 144 + (16 * ks + 8 * hh) * 2);
#pragma unroll
            for (int tl = 0; tl < 4; ++tl) {
                const int tt = 4 * blk + tl, j0 = 32 * tt;
                {
                    f32x16 X;
#pragma unroll
                    for (int i = 0; i < 16; ++i) X[i] = 0.f;
#pragma unroll
                    for (int ks = 0; ks < 4; ++ks) X = MFMA32(af[ks], bq[ks], X);
#ifdef IDX_PROBE_NOLDS
                    if (tl < 3 && sel) {
#else
                    if (tl < 3) {
#endif
#pragma unroll
                        for (int ks = 0; ks < 4; ++ks) bq[ks] = ldsb128(kb + (32 * (tl + 1) + r) * 144 + (16 * ks + 8 * hh) * 2);
                    }
                    float s0, s1, s2, s3;
#if IDX_ASM_FMA
#define IDX_ACC0(sv, hd_) do { const float x_ = X[hd_]; const float t_ = __builtin_bit_cast(float, max(__builtin_bit_cast(int, x_), 0)); asm("v_mul_f32 %0, %1, %2" : "=v"(sv) : "v"(wv[hd_]), "v"(t_)); } while (0)
                    IDX_ACC0(s0, 0); IDX_ACC0(s1, 1); IDX_ACC0(s2, 2); IDX_ACC0(s3, 3);
#undef IDX_ACC0
#else
                    s0 = s1 = s2 = s3 = 0.f;
#endif
#if IDX_ASM_FMA
#define IDX_ACC(sv, hd_) do { const float x_ = X[hd_];   const float t_ = __builtin_bit_cast(float, max(__builtin_bit_cast(int, x_), 0)); asm("v_fma_f32 %0, %1, %2, %0" : "+v"(sv) : "v"(wv[hd_]), "v"(t_)); } while (0)
#else
#define IDX_ACC(sv, hd_) do { const float x_ = X[hd_]; sv = fmaf(wv[hd_], __builtin_bit_cast(float, max(__builtin_bit_cast(int, x_), 0)), sv); } while (0)
#endif
#pragma unroll
                    for (int hd = IDX_ASM_FMA ? 4 : 0; hd < 16; hd += 4) { IDX_ACC(s0, hd); IDX_ACC(s1, hd + 1); IDX_ACC(s2, hd + 2); IDX_ACC(s3, hd + 3); }
#undef IDX_ACC
                    key[tt] = f2key((s0 + s1) + (s2 + s3)) & ~(unsigned)((vlim - j0) >> 31);
                    __builtin_amdgcn_sched_barrier(0);
                }
            }
        }
    }
    if (!sel) {
        unsigned x = 0u;
#pragma unroll
        for (int k = 0; k < 128; ++k) x ^= key[k];
        if (x == 0x9e3779b9u) F.CNT[0] = (int)x;
        __syncthreads();
        return;
    }
#if REP_IDX == 4
    for (int selrep_ = 0; selrep_ < 2; ++selrep_) {
#endif
    unsigned T = 0u; asm volatile("" : "+v"(T));
    bool done = (tq + 1 <= KSEL);
    if (tq0 + 2 * w + 2 > KSEL) {
#pragma unroll 1
        for (int bit = 31; bit >= 0; --bit) {
            const unsigned cand = T | (1u << bit);
            int c = 0;
#pragma unroll
            for (int grp = 0; grp < 8; ++grp) {
                if (4 * grp < nblk) {
#pragma unroll
                    for (int k = 0; k < 16; ++k) c += (key[16 * grp + k] >= cand) ? 1 : 0;
                }
            }
            c = half_sum_dpp(c, hh);
            T = (!done && c >= KSEL) ? cand : T;
            done = done || (c == KSEL);
            if (__all(done)) break;
        }
    }
    if (tq + 1 <= KSEL) T = 0u;
    else if (done) T -= 1u;
    int g0, g1;
    { int c = 0;
#pragma unroll
      for (int grp = 0; grp < 8; ++grp) {
          if (4 * grp < nblk) {
#pragma unroll
              for (int k = 0; k < 16; ++k) c += (key[16 * grp + k] > T) ? 1 : 0;
          }
      }
      c = half_sum_dpp(c, hh);
      g0 = __builtin_amdgcn_readlane(c, 0); g1 = __builtin_amdgcn_readlane(c, 32); }
    int rem0 = (tq0 + 2 * w + 1 > KSEL) ? KSEL - g0 : 0, rem1 = (tq0 + 2 * w + 2 > KSEL) ? KSEL - g1 : 0;
    unsigned mw0 = 0u, mw1 = 0u, mw2 = 0u, mw3 = 0u;
    if ((rem0 | rem1) == 0) {
#pragma unroll
        for (int blk = 0; blk < 32; ++blk) {
            if (blk < nblk) {
#pragma unroll
                for (int tl = 0; tl < 4; ++tl) {
                    const int tt = 4 * blk + tl;
                    const unsigned long long mg = __ballot(key[tt] > T);
                    const unsigned w0 = (unsigned)mg, w1 = (unsigned)(mg >> 32);
                    if (tt < 64) { WRITELANE(mw0, w0, tt & 63); WRITELANE(mw2, w1, tt & 63); } else { WRITELANE(mw1, w0, tt & 63); WRITELANE(mw3, w1, tt & 63); }
                }
            }
        }
    } else {
#pragma unroll
        for (int blk = 0; blk < 32; ++blk) {
            if (blk < nblk) {
#pragma unroll
                for (int tl = 0; tl < 4; ++tl) {
                    const int tt = 4 * blk + tl;
                    const unsigned long long mg = __ballot(key[tt] > T), me = __ballot(key[tt] == T);
                    unsigned e0 = (unsigned)me, e1 = (unsigned)(me >> 32);
                    while (__popc(e0) > rem0) e0 &= ~(0x80000000u >> __clz(e0));
                    while (__popc(e1) > rem1) e1 &= ~(0x80000000u >> __clz(e1));
                    rem0 -= __popc(e0); rem1 -= __popc(e1);
                    const unsigned w0 = (unsigned)mg | e0, w1 = (unsigned)(mg >> 32) | e1;
                    if (tt < 64) { WRITELANE(mw0, w0, tt & 63); WRITELANE(mw2, w1, tt & 63); } else { WRITELANE(mw1, w0, tt & 63); WRITELANE(mw3, w1, tt & 63); }
                    __builtin_amdgcn_sched_barrier(0);
                }
            }
        }
    }
    unsigned* mrow = F.MASK + (size_t)(m0 + 2 * w) * 128;
    mrow[lane] = mw0; mrow[64 + lane] = mw1; mrow[128 + lane] = mw2; mrow[192 + lane] = mw3;
#if REP_IDX == 4
    }
#endif
    __syncthreads();
}

#ifndef ATT_SETPRIO
#define ATT_SETPRIO 1
#endif
#if ATT_SETPRIO
#define ATT_PRIO(p) __builtin_amdgcn_s_setprio(p)
#else
#define ATT_PRIO(p) ((void)0)
#endif
__device__ __forceinline__ void attn2_unit(Frame& F, int li, int b, int kvh, int qb) {
    const int tid = F.tid_(), lane = F.lane_(), w = F.wave_(), r = lane & 31, hh = lane >> 5, blk = (lane >> 4) & 1, q4 = (lane >> 2) & 3, p4 = lane & 3;
    const int g = w & 3, qs = w >> 2, hq = kvh * 4 + g, i0 = 64 * qb + 32 * qs, ti = i0 + r;
    const size_t mrow = (size_t)b * SEQ + ti;
    const bf16* Pb = F.P + (size_t)b * SEQ * NP_O;
    constexpr int KST = 272, VST = 320, BUFB = 128 * KST + 128 * VST;
    LAS float* BT = (LAS float*)(F.lds + 2 * BUFB);
    constexpr float LOG2E = 1.4426950408889634f, SC = 0.08838834764831845f * LOG2E;
    { const int gg = tid >> 7, dist = tid & 127; BT[tid] = F.in(I_RELB)[(int)T5B[dist] * 16 + kvh * 4 + gg] * LOG2E; }
    bf16x8 qf[8];
    { const bf16* qrow = Pb + (size_t)ti * NP_O + OC_Q + hq * 128 + 8 * hh;
#pragma unroll
      for (int ks = 0; ks < 8; ++ks) qf[ks] = *(const bf16x8*)(qrow + 16 * ks); }
    float mi;
    { float qq = 0.f;
#pragma unroll
      for (int ks = 0; ks < 8; ++ks) { const v4u qv = __builtin_bit_cast(v4u, qf[ks]); qq = dot2bf(qv.x, qv.x, qq); qq = dot2bf(qv.y, qv.y, qq); qq = dot2bf(qv.z, qv.z, qq); qq = dot2bf(qv.w, qv.w, qq); }
      qq += __shfl_xor(qq, 32);
      const float k2 = __builtin_bit_cast(float, F.KMAX[li * 16 + b * 4 + kvh]);
      float bm = -INFINITY; const float* rb = F.in(I_RELB) + hq;
#pragma unroll 8
      for (int bk = 0; bk < 32; ++bk) bm = fmaxf(bm, rb[bk * 16]);
      mi = SC * sqrtf(qq * k2) + bm * LOG2E; }
    f32x16 o[4];
#pragma unroll
    for (int dt = 0; dt < 4; ++dt)
#pragma unroll
        for (int i = 0; i < 16; ++i) o[dt][i] = 0.f;
    float l_run = 0.f;
    const int nkb = (qb >> 1) + 1;
    const int srow = tid >> 4, spc = tid & 15;
    const bf16* sK = Pb + (size_t)srow * NP_O + OC_K + kvh * 128 + spc * 8;
    const bf16* sV = Pb + (size_t)srow * NP_O + OC_V + kvh * 128 + spc * 8;
    v4u st[8];
#pragma unroll
    for (int i = 0; i < 4; ++i) { st[i] = *(const v4u*)(sK + (size_t)(32 * i) * NP_O); st[4 + i] = *(const v4u*)(sV + (size_t)(32 * i) * NP_O); }
    const unsigned* mbase = F.MASK + mrow * 128;
    v4u mwn = *(const v4u*)mbase;
#pragma unroll 1
    for (int kb = 0; kb < nkb; ++kb) {
        LAS unsigned char* Kim = F.lds + (kb & 1) * BUFB; LAS unsigned char* Vim = Kim + 128 * KST;
#pragma unroll
        for (int i = 0; i < 4; ++i) { *(LAS v4u*)(Kim + (srow + 32 * i) * KST + spc * 16) = st[i]; *(LAS v4u*)(Vim + (srow + 32 * i) * VST + spc * 16) = st[4 + i]; }
        const v4u mw = mwn;
        if (kb + 1 < nkb) { const size_t off = (size_t)(128 * (kb + 1)) * NP_O;
#pragma unroll
            for (int i = 0; i < 4; ++i) { st[i] = *(const v4u*)(sK + off + (size_t)(32 * i) * NP_O); st[4 + i] = *(const v4u*)(sV + off + (size_t)(32 * i) * NP_O); }
            mwn = *(const v4u*)(mbase + 4 * (kb + 1)); }
        __syncthreads();
#pragma unroll
        for (int jt = 0; jt < 4; ++jt) {
            const int j0 = 128 * kb + 32 * jt;
            if (j0 <= i0 + 31) {
                f32x16 X;
#pragma unroll
                for (int i = 0; i < 16; ++i) X[i] = 0.f;
                ATT_PRIO(1);
#pragma unroll
                for (int ks = 0; ks < 8; ++ks) X = MFMA32(ldsb128(Kim + (32 * jt + r) * KST + (16 * ks + 8 * hh) * 2), qf[ks], X);
                ATT_PRIO(0);
                const unsigned word = (jt == 0 ? mw.x : jt == 1 ? mw.y : jt == 2 ? mw.z : mw.w) >> (4 * hh);
                if (j0 + 31 + 128 > i0) {
                    const LAS float* bt = BT + g * 128; const int dbase = ti - j0 - 4 * hh;
#pragma unroll
                    for (int reg = 0; reg < 16; ++reg) { int dd = dbase - ((reg & 3) + 8 * (reg >> 2)); dd = dd < 0 ? 0 : (dd > 127 ? 127 : dd); X[reg] = fmaf(X[reg], SC, bt[dd] - mi); }
                } else {
                    const float bfar = BT[g * 128 + 127] - mi;
#pragma unroll
                    for (int reg = 0; reg < 16; ++reg) X[reg] = fmaf(X[reg], SC, bfar);
                }
                float ls = 0.f;
#pragma unroll
                for (int reg = 0; reg < 16; ++reg) {
                    unsigned t; asm("v_bfe_i32 %0, %1, %2, 1" : "=v"(t) : "v"(word), "n"((reg & 3) + 8 * (reg >> 2)));
                    X[reg] = __builtin_bit_cast(float, __builtin_bit_cast(unsigned, __builtin_amdgcn_exp2f(X[reg])) & t); ls += X[reg]; }
                l_run += ls;
                const bf16x8 xs0 = pack8(X, 0), xs1 = pack8(X, 1);
                ATT_PRIO(1);
#pragma unroll
                for (int dt = 0; dt < 4; ++dt) {
                    const LAS unsigned char* pa = Vim + (32 * jt + 4 * hh + q4) * VST + (32 * dt + 16 * blk + 4 * p4) * 2;
                    o[dt] = MFMA32(cat8(tr16(pa), tr16(pa + 8 * VST)), xs0, o[dt]);
                    o[dt] = MFMA32(cat8(tr16(pa + 16 * VST), tr16(pa + 24 * VST)), xs1, o[dt]);
                }
                ATT_PRIO(0);
            }
        }
    }
    const float inv = 1.f / (l_run + __shfl_xor(l_run, 32));
    bf16* orow = F.AB + mrow * D + hq * 128;
#pragma unroll
    for (int dt = 0; dt < 4; ++dt)
#pragma unroll
        for (int g4 = 0; g4 < 4; ++g4) { v2u ov; ov.x = cvtpk(o[dt][4 * g4 + 0] * inv, o[dt][4 * g4 + 1] * inv); ov.y = cvtpk(o[dt][4 * g4 + 2] * inv, o[dt][4 * g4 + 3] * inv);
            *(v2u*)(orow + 32 * dt + 8 * g4 + 4 * hh) = ov; }
    __syncthreads();
}
__device__ __forceinline__ void attn2_phase(Frame& F, int li) {
    if (F.G == 256) {
        const int c = (int)blockIdx.x;
#pragma unroll 1
        for (int rr = 0; rr < 4; ++rr) { const int combo = c & 15, qsel = c >> 4, qb = (rr & 1) ? 16 * rr + 15 - qsel : 16 * rr + qsel; attn2_unit(F, li, combo >> 2, combo & 3, qb); }
    } else {
        for (int u = (int)blockIdx.x; u < 1024; u += F.G) attn2_unit(F, li, (u & 15) >> 2, u & 3, u >> 4);
    }
}

#ifndef MK_SPLIT
#define MK_SPLIT 0
#endif
constexpr int NPH = 2 + 7 * DEPTH;
#ifndef F8_FFN1_MASK
#define F8_FFN1_MASK 0x8
#endif
#ifndef F8_FFN2_MASK
#define F8_FFN2_MASK 0xC
#endif
#ifndef FFN_HALVES
#define FFN_HALVES 1
#endif
#ifndef REP_PRO
#define REP_PRO 1
#endif
#ifndef REP_NORM
#define REP_NORM 1
#endif
#ifndef REP_INPROJ
#define REP_INPROJ 1
#endif
#ifndef REP_GLA
#define REP_GLA 1
#endif
#ifndef REP_IDX
#define REP_IDX 1
#endif
#ifndef REP_ATTN
#define REP_ATTN 1
#endif
#ifndef REP_FFN1
#define REP_FFN1 1
#endif
#define REPEAT(n) for (int rep_ = 0; rep_ < ((n) == 3 ? 2 : ((n) == 4 ? 1 : (n))); ++rep_)
#define IN(k) (lo <= (k) && (k) < hi)
#ifndef REP_BAR
#define REP_BAR 1
#endif
#define SEAM(k) do { if (IN(k) && IN((k) + 1)) { xcd_barrier(bar); if (REP_BAR > 1) xcd_barrier(bar); } } while (0)
template <int L> __device__ __forceinline__ void layer_body(Frame& F, const XcdBarrier& bar, const int lo, const int hi) {
        constexpr int pb = 1 + 7 * L, li = L >> 1; constexpr bool odd = (L & 1) != 0, f8 = ((F8_FFN2_MASK >> L) & 1) != 0, f81 = ((F8_FFN1_MASK >> L) & 1) != 0;
        if (IN(pb + 0)) {
            constexpr int NP = odd ? NP_O : NP_E, NMAIN = odd ? 4096 : 5120;
            const bf16* Wt = odd ? F.Wcin + (size_t)li * NP_O * D : F.Wabin + (size_t)li * NP_E * D;
            pg8::Gemm g{F.HB, Wt, M, NMAIN, D}; pg8::StaticOrder S; S.init(M, NMAIN, F.G, (int)blockIdx.x);
            pg8::EpiInProj E{F.P, NP, odd ? 0 : 2048, F.RSS + (size_t)(2 * L) * M};
            REPEAT(REP_INPROJ) pg8::gemm_phase<pg8::EpiInProj, pg8::StaticOrder, true, true>(F.lds, g, S, E);
            inproj_tail<odd ? 5 : 1>(F, Wt + (size_t)NMAIN * D, F.RSS + (size_t)(2 * L) * M, F.P + NMAIN, NP);
        }
        SEAM(pb + 0);
        if constexpr (!odd) {
            if (IN(pb + 1)) REPEAT(REP_GLA) { for (int u = (int)blockIdx.x; u < 256; u += F.G) gla_a_unit(F, li, u); }
            SEAM(pb + 1);
            if (IN(pb + 2)) REPEAT(REP_GLA) { gla_scan(F); for (int u = (int)blockIdx.x; u < 1024; u += F.G) sgu2_unit(F, li, u); }
            SEAM(pb + 2);
            if (IN(pb + 3)) REPEAT(REP_GLA) { for (int u = (int)blockIdx.x; u < 256; u += F.G) gla_c_unit(F, li, u); }
            SEAM(pb + 3);
        } else {
            if (IN(pb + 1)) REPEAT(REP_IDX) { int rr_ = 0; for (int u = (int)blockIdx.x; u < M / 16; u += F.G, ++rr_) idx2_unit(F, li, (rr_ & 1) ? (u & ~255) + 255 - (u & 255) : u, REP_IDX != 3 || rep_ == 0);   }
            SEAM(pb + 1);
            if (IN(pb + 2)) REPEAT(REP_ATTN) attn2_phase(F, li);
            SEAM(pb + 2);
        }
        if (IN(pb + 4)) {
            pg8::Gemm g{F.AB, odd ? F.Wcout + (size_t)li * D * D : F.Wabout + (size_t)li * D * D, M, D, D}; pg8::StaticOrder S; S.init(M, D, F.G, (int)blockIdx.x);
            pg8::EpiResBf16<false, f81> E{F.HB, D, F.RSS + (size_t)(2 * L + 1) * M, nullptr, (unsigned char*)F.DS  };
            pg8::gemm_phase<pg8::EpiResBf16<false, f81>, pg8::StaticOrder, true, true>(F.lds, g, S, E);
#if JIT_WEIGHTS
            convert_ffn(F, L, -1, f8, f81);
#endif
        }
        SEAM(pb + 4);
#if FFN_HALVES
        if (IN(pb + 5)) {
#define FFN_HALF(hf, PRE, POST) do { \
            { pg8::Gemm g{f81 ? (const bf16*)((const unsigned char*)F.DS + (size_t)(hf) * (M / 2) * D) : F.HB + (size_t)(hf) * (M / 2) * D, F.Wf1 + (size_t)L * FF * D, M / 2, FF, D, 127 - 9}; pg8::StaticOrder S; S.init(M / 2, FF, F.G, (int)blockIdx.x); \
              if constexpr (f8) { pg8::EpiRelu2F8 E{(unsigned char*)F.P + (size_t)(hf) * (M / 2) * FF, FF, F.RSS + (size_t)(2 * L + 1) * M + (size_t)(hf) * (M / 2)}; \
                  pg8::gemm_phase<pg8::EpiRelu2F8, pg8::StaticOrder, true, true, f81>(F.lds, g, S, E); } \
              else { pg8::EpiRelu2 E{F.P + (size_t)(hf) * (M / 2) * FF, FF, F.RSS + (size_t)(2 * L + 1) * M + (size_t)(hf) * (M / 2)}; \
                  pg8::gemm_phase<pg8::EpiRelu2, pg8::StaticOrder, true, true, f81>(F.lds, g, S, E); } } \
            xcd_barrier(bar); \
            PRE; \
            { pg8::Gemm g{f8 ? (const bf16*)((const unsigned char*)F.P + (size_t)(hf) * (M / 2) * FF) : F.P + (size_t)(hf) * (M / 2) * FF, F.Wf2 + (size_t)L * D * FF, M / 2, D, FF}; pg8::StaticOrder S; S.init(M / 2, D, F.G, (int)blockIdx.x); \
              pg8::EpiResBf16<false> E{F.HB + (size_t)(hf) * (M / 2) * D, D, F.RSS + (size_t)(2 * L + 2) * M + (size_t)(hf) * (M / 2), nullptr}; \
              pg8::gemm_phase<pg8::EpiResBf16<false>, pg8::StaticOrder, true, true, f8>(F.lds, g, S, E); } \
            POST; } while (0)
            FFN_HALF(0, (void)0, (void)0);
#if JIT_WEIGHTS
            FFN_HALF(1, (void)0, do { if constexpr (L + 1 < DEPTH) convert_inout(F, L + 1); } while (0));
#else
            FFN_HALF(1, (void)0, (void)0);
#endif
#undef FFN_HALF
        }
#else
        if (IN(pb + 5)) {
            pg8::Gemm g{F.HB, F.Wf1 + (size_t)L * FF * D, M, FF, D}; pg8::StaticOrder S; S.init(M, FF, F.G, (int)blockIdx.x);
            pg8::EpiRelu2 E{F.P, FF, F.RSS + (size_t)(2 * L + 1) * M};
#if REP_FFN1 == 3
            { pg8::EpiNull E0{F.P}; pg8::gemm_phase<pg8::EpiNull, pg8::StaticOrder, true, true>(F.lds, g, S, E0); }
            pg8::gemm_phase<pg8::EpiRelu2, pg8::StaticOrder, true, true>(F.lds, g, S, E);
#else
            REPEAT(REP_FFN1) pg8::gemm_phase<pg8::EpiRelu2, pg8::StaticOrder, true, true>(F.lds, g, S, E);
#endif
        }
        SEAM(pb + 5);
        if (IN(pb + 6)) {
            pg8::Gemm g{F.P, F.Wf2 + (size_t)L * D * FF, M, D, FF}; pg8::StaticOrder S; S.init(M, D, F.G, (int)blockIdx.x);
            pg8::EpiResBf16<false> E{F.HB, D, F.RSS + (size_t)(2 * L + 2) * M, nullptr};
#if defined(REP_FFN2) && REP_FFN2 > 1
            { pg8::EpiResBf16<false> E2{F.AB, D, (unsigned long long*)F.IDX, nullptr}; pg8::gemm_phase<pg8::EpiResBf16<false>, pg8::StaticOrder, true, true>(F.lds, g, S, E2); }
#endif
            pg8::gemm_phase<pg8::EpiResBf16<false>, pg8::StaticOrder, true, true>(F.lds, g, S, E);
        }
#endif
        SEAM(pb + 6);
}
struct Args { const float* in[17]; float* out; unsigned char* ws; int ph_lo, ph_hi; };
__global__ void __launch_bounds__(NWAVES * 64, 2) fwd(Args args) {
    extern __shared__ __attribute__((aligned(16))) unsigned char lds_raw[];
    Frame F;
    F.lds = (LAS unsigned char*)lds_raw;
    F.MISC = (volatile LAS unsigned*)(F.lds + LDSCTL_OFF);
    F.G = gridDim.x;
    unsigned char* ws = args.ws;
    F.ctl = (gu32*)(ws + WS_CTL);
    F.out = args.out;
    F.Wabin = (bf16*)(ws + WS_WABIN); F.Wabout = (bf16*)(ws + WS_WABOUT); F.Wcin = (bf16*)(ws + WS_WCIN); F.Wcout = (bf16*)(ws + WS_WCOUT); F.Wf1 = (bf16*)(ws + WS_WF1); F.Wf2 = (bf16*)(ws + WS_WF2);
    F.HB = (bf16*)(ws + WS_HB); F.RSS = (unsigned long long*)(ws + WS_RSS); F.KMAX = (unsigned*)(ws + WS_KMAX); F.AB = (bf16*)(ws + WS_AB); F.P = (bf16*)(ws + WS_P); F.IDX = (int*)(ws + WS_IDX); F.CNT = (int*)(ws + WS_CNT);
    F.QE = (bf16*)(ws + WS_QE); F.KE = (bf16*)(ws + WS_KE); F.SP = (bf16*)(ws + WS_SP); F.DS = (float*)(ws + WS_DS); F.LAST = (float*)(ws + WS_LAST); F.MASK = (unsigned*)(ws + WS_MASK); F.WSB = (bf16*)(ws + WS_WSB);
    for (int u = F.tid_(); u < (LDS_BYTES - LDSCTL_OFF) / 4; u += NWAVES * 64) ((LAS unsigned*)(F.lds + LDSCTL_OFF))[u] = 0u;
    __syncthreads();
    if (F.tid_() < 17) { const unsigned long long p = (unsigned long long)args.in[F.tid_()]; F.MISC[32 + 2 * F.tid_()] = (unsigned)p; F.MISC[33 + 2 * F.tid_()] = (unsigned)(p >> 32); }
    __syncthreads();
    const int lo = args.ph_lo, hi = args.ph_hi;
    XcdBarrier bar = xcd_barrier_post((unsigned*)(F.ctl + CW_BAR) + (MK_SPLIT ? lo : 0) * XCD_BAR_WORDS, F.MISC + 8);

    if (IN(0)) REPEAT(REP_PRO) { p0_prologue(F); } SEAM(0);
    layer_body<0>(F, bar, lo, hi);
    layer_body<1>(F, bar, lo, hi);
    layer_body<2>(F, bar, lo, hi);
    layer_body<3>(F, bar, lo, hi);
    if (IN(NPH - 1)) final_norm_phase(F, F.in(I_FNG), F.RSS + (size_t)8 * M, F.HB, F.out);
#undef IN
#undef SEAM
}

extern "C" void kernel_launch(void* const* d_in, const int* in_sizes, int n_in, void* d_out, int out_size, void* d_ws, size_t ws_size, hipStream_t stream) {
    static int grid = 0;
    if (grid == 0) {
        if (n_in != 17 || in_sizes[0] != M * D || out_size != M * D || ws_size < WS_END) { fprintf(stderr, "kernel_launch: unexpected shapes (n_in %d, in0 %d, out %d, ws %zu < %zu); nothing launched\n", n_in, n_in > 0 ? in_sizes[0] : -1, out_size, ws_size, (size_t)WS_END); grid = -1; return; }
        int dev = 0, cus = 0, per_cu = 0;
        if (hipGetDevice(&dev) != hipSuccess || hipDeviceGetAttribute(&cus, hipDeviceAttributeMultiprocessorCount, dev) != hipSuccess) { grid = -1; return; }
        if (hipFuncSetAttribute((const void*)fwd, hipFuncAttributeMaxDynamicSharedMemorySize, LDS_BYTES) != hipSuccess) { fprintf(stderr, "kernel_launch: hipFuncSetAttribute failed\n"); grid = -1; return; }
        if (hipOccupancyMaxActiveBlocksPerMultiprocessor(&per_cu, (const void*)fwd, NWAVES * 64, LDS_BYTES) != hipSuccess || per_cu < 1) { fprintf(stderr, "kernel_launch: occupancy query reports %d\n", per_cu); }
        (void)hipGetLastError();
        grid = cus;
    }
    if (grid < 0) return;
    if (hipMemsetAsync((char*)d_ws + WS_CTL, 0, CTL_ZERO_BYTES, stream) != hipSuccess) return;
    Args a{};
    for (int i = 0; i < 17; ++i) a.in[i] = (const float*)d_in[i];
    a.out = (float*)d_out; a.ws = (unsigned char*)d_ws;
#if MK_SPLIT
    for (int p = 0; p < NPH; ++p) {
        if (p >= 1 && p < NPH - 1) { const int L = (p - 1) / 7, k = (p - 1) % 7; if ((L & 1) && k == 3) continue; }
        a.ph_lo = p; a.ph_hi = p + 1;
        hipLaunchKernelGGL(fwd, dim3(grid), dim3(NWAVES * 64), LDS_BYTES, stream, a);
    }
#else
    a.ph_lo = 0; a.ph_hi = NPH;
    hipLaunchKernelGGL(fwd, dim3(grid), dim3(NWAVES * 64), LDS_BYTES, stream, a);
#endif
}
```

```cpp
#include <hip/hip_runtime.h>
#include <cstdio>
#include <cstdint>
namespace pg8 {
#define PG8_LAS __attribute__((address_space(3)))
typedef unsigned short bf16_t;
typedef short bf16x8 __attribute__((ext_vector_type(8)));
typedef float f32x4 __attribute__((ext_vector_type(4)));
typedef unsigned u32x4 __attribute__((ext_vector_type(4)));
constexpr int BM = 256, BK = 64, HALF = 128, HTB = HALF * BK * 2  , STAGE_BYTES = 8 * HTB, NXCD = 8, WGM = 8;

__host__ __device__ __forceinline__ int lds_byte(int r, int c) { const int st = (r >> 4) * 2 + (c >> 5), rr = r & 15, cc = c & 31, ob = rr * 64 + cc * 2; return st * 1024 + (ob ^ (((ob >> 9) & 1) << 5)); }
__host__ __device__ __forceinline__ void stage_rc(int b, int& R, int& C) { const int st = b / 1024, sb = b % 1024, swz = sb ^ (((sb >> 9) & 1) << 5); R = (st >> 1) * 16 + swz / 64; C = (st & 1) * 32 + (swz % 64) / 2; }
__host__ __device__ __forceinline__ int perm32(int rho) { const int n = rho >> 4, i = rho & 15; return 8 * (i >> 2) + 4 * n + (i & 3); }

struct Unit { int pm, pn; };
struct Gemm { const bf16_t* A; const bf16_t* Bt; int M, N, K; int wscale = 127 - 10; };

struct StaticOrder {
    int nM, nN, nwg, G, c;
    __host__ __device__ void init(int M, int N, int G_, int c_) { nM = M / BM; nN = N / BM; nwg = nM * nN; G = G_; c = c_; }
    __host__ __device__ bool next(int i, Unit& u) const {
        const long L = (long)i * G + c; if (L >= nwg) return false;
        int wgid = (int)L; { const int q = nwg / NXCD, r = nwg % NXCD, xcd = wgid % NXCD, off = wgid / NXCD; wgid = (xcd < r ? xcd * (q + 1) : r * (q + 1) + (xcd - r) * q) + off; }
        const int nig = WGM * nN, gid = wgid / nig, fm = gid * WGM, gsz = (nM - fm) < WGM ? (nM - fm) : WGM;
        u.pm = fm + ((wgid % nig) % gsz); u.pn = (wgid % nig) / gsz; return true;
    }
    __device__ __forceinline__ void a_ready(const Unit&) const {}
    __device__ __forceinline__ void done(const Unit&) const {}
};

__device__ __forceinline__ unsigned cvt_pk_bf16(float lo, float hi) { unsigned r; asm volatile("v_cvt_pk_bf16_f32 %0, %1, %2" : "=v"(r) : "v"(lo), "v"(hi)); return r; }
typedef float f32x2 __attribute__((ext_vector_type(2)));
#ifndef WT_STORES
#define WT_STORES 0
#endif
__device__ __forceinline__ void store16_wt(void* p, u32x4 v) {
#if WT_STORES == 1
    asm volatile("global_store_dwordx4 %0, %1, off sc1\n\ts_nop 1" :: "v"(p), "v"(v));
#elif WT_STORES == 2
    __builtin_nontemporal_store(v, (u32x4*)p);
#else
    *(u32x4*)p = v;
#endif
}
__device__ __forceinline__ f32x2 gelu_pk(f32x2 v) {
    const f32x2 av = __builtin_elementwise_abs(v), d = av * 0.2316418882f + 1.0f;
    f32x2 t; t.x = __builtin_amdgcn_rcpf(d.x); t.y = __builtin_amdgcn_rcpf(d.y);
    f32x2 q = t * 0.5307027145f + (-0.7265760135f); q = q * t + 0.7107068705f; q = q * t + (-0.142248368f); q = q * t + 0.127414796f; q = q * t;
    const f32x2 s = (v * v) * (-0.72134752044f);
    f32x2 e; e.x = __builtin_amdgcn_exp2f(s.x); e.y = __builtin_amdgcn_exp2f(s.y);
    const f32x2 m = v * (q * e), r = v - m;
    f32x2 o; o.x = v.x < 0.f ? m.x : r.x; o.y = v.y < 0.f ? m.y : r.y; return o;
}

constexpr float RSS_SCALE = 65536.f, RSS_INV = 1.f / (65536.f * 2048.f), NORM_EPS = 1e-6f;
struct PreRss { unsigned long long v[2][4]; };
struct PreNone {};
__device__ __forceinline__ void prefetch_rss(PreRss& p, const unsigned long long* rss, int row0) {
#pragma unroll
    for (int ai = 0; ai < 2; ++ai)
#pragma unroll
        for (int m = 0; m < 4; ++m) asm volatile("global_load_dwordx2 %0, %1, off" : "=&v"(p.v[ai][m]) : "v"(rss + row0 + ai * HALF + m * 16) : "memory");
}
__device__ __forceinline__ void load_rstd(PreRss& p, float (&rs)[2][4]) {
    asm volatile("s_waitcnt vmcnt(16)" : "+v"(p.v[0][0]), "+v"(p.v[0][1]), "+v"(p.v[0][2]), "+v"(p.v[0][3]), "+v"(p.v[1][0]), "+v"(p.v[1][1]), "+v"(p.v[1][2]), "+v"(p.v[1][3]) :: "memory");
#pragma unroll
    for (int ai = 0; ai < 2; ++ai)
#pragma unroll
        for (int m = 0; m < 4; ++m) rs[ai][m] = rsqrtf((float)p.v[ai][m] * RSS_INV + NORM_EPS);
}
struct EpiInProj {
    static constexpr bool PERM = true, AFTER_DRAIN = false;
    bf16_t* O; int ldc; int gelu_cols; const unsigned long long* rss;
    typedef PreRss Pre;
    __device__ __forceinline__ void prefetch(Pre& p, const Unit& u, int wr, int fr) const { prefetch_rss(p, rss, u.pm * BM + wr * 64 + fr); }
    __device__ __forceinline__ void operator()(const f32x4 (&acc)[2][2][4][2], const Unit& u, int wr, int wc, int fr, int fq, Pre& pre) const {
        const int row0 = u.pm * BM + wr * 64 + fr, col0 = u.pn * BM + wc * 32 + 8 * fq;
        const bool g = (u.pn * BM) < gelu_cols;
        float rs[2][4]; load_rstd(pre, rs);
#pragma unroll
        for (int ai = 0; ai < 2; ++ai)
#pragma unroll
            for (int m = 0; m < 4; ++m) { bf16_t* rowp = O + (size_t)(row0 + ai * HALF + m * 16) * ldc + col0;
#pragma unroll
                for (int bj = 0; bj < 2; ++bj) { f32x4 v0 = acc[ai][bj][m][0] * rs[ai][m], v1 = acc[ai][bj][m][1] * rs[ai][m];
                    if (g) { f32x2 a = gelu_pk((f32x2){v0[0], v0[1]}), b = gelu_pk((f32x2){v0[2], v0[3]}), c = gelu_pk((f32x2){v1[0], v1[1]}), d = gelu_pk((f32x2){v1[2], v1[3]});
                        v0 = (f32x4){a.x, a.y, b.x, b.y}; v1 = (f32x4){c.x, c.y, d.x, d.y}; }
                    u32x4 w; w.x = cvt_pk_bf16(v0[0], v0[1]); w.y = cvt_pk_bf16(v0[2], v0[3]); w.z = cvt_pk_bf16(v1[0], v1[1]); w.w = cvt_pk_bf16(v1[2], v1[3]);
                    store16_wt(rowp + bj * HALF, w); } }
    }
};
struct EpiRelu2 {
    static constexpr bool PERM = true, AFTER_DRAIN = false;
    bf16_t* O; int ldc; const unsigned long long* rss;
    typedef PreRss Pre;
    __device__ __forceinline__ void prefetch(Pre& p, const Unit& u, int wr, int fr) const { prefetch_rss(p, rss, u.pm * BM + wr * 64 + fr); }
    __device__ __forceinline__ void operator()(const f32x4 (&acc)[2][2][4][2], const Unit& u, int wr, int wc, int fr, int fq, Pre& pre) const {
        const int row0 = u.pm * BM + wr * 64 + fr, col0 = u.pn * BM + wc * 32 + 8 * fq;
        float rs[2][4]; load_rstd(pre, rs);
#pragma unroll
        for (int ai = 0; ai < 2; ++ai)
#pragma unroll
            for (int m = 0; m < 4; ++m) { bf16_t* rowp = O + (size_t)(row0 + ai * HALF + m * 16) * ldc + col0;
#pragma unroll
                for (int bj = 0; bj < 2; ++bj) { f32x4 v0 = acc[ai][bj][m][0] * rs[ai][m], v1 = acc[ai][bj][m][1] * rs[ai][m];
#pragma unroll
                    for (int j = 0; j < 4; ++j) { const float a = fmaxf(v0[j], 0.f), b = fmaxf(v1[j], 0.f); v0[j] = a * a; v1[j] = b * b; }
                    u32x4 w; w.x = cvt_pk_bf16(v0[0], v0[1]); w.y = cvt_pk_bf16(v0[2], v0[3]); w.z = cvt_pk_bf16(v1[0], v1[1]); w.w = cvt_pk_bf16(v1[2], v1[3]);
                    store16_wt(rowp + bj * HALF, w); } }
    }
};
typedef int i32x8 __attribute__((ext_vector_type(8)));
typedef int i32x4 __attribute__((ext_vector_type(4)));
__device__ __forceinline__ i32x8 cat_f8(bf16x8 a, bf16x8 b) { return __builtin_shufflevector(__builtin_bit_cast(i32x4, a), __builtin_bit_cast(i32x4, b), 0, 1, 2, 3, 4, 5, 6, 7); }
constexpr float F8_MAX = 448.f;
constexpr int F8_WSCALE_E8M0 = 127 - 10;
__device__ __forceinline__ unsigned pk4_fp8(float a, float b, float c, float d) {
    int r = __builtin_amdgcn_cvt_pk_fp8_f32(a, b, 0, false); r = __builtin_amdgcn_cvt_pk_fp8_f32(c, d, r, true); return (unsigned)r; }
typedef unsigned u32x2 __attribute__((ext_vector_type(2)));
__device__ __forceinline__ void mfma_f8_acc(f32x4& acc, i32x8 a, i32x8 b, int sc) {
    asm volatile("v_mfma_scale_f32_16x16x128_f8f6f4 %0, %1, %2, %0, %3, %3 op_sel:[0,1,0] op_sel_hi:[0,0,0]" : "+v"(acc) : "v"(a), "v"(b), "v"(sc));
}
struct EpiRelu2F8 {
    static constexpr bool PERM = true, AFTER_DRAIN = false;
    unsigned char* O; int ldc; const unsigned long long* rss;
    typedef PreRss Pre;
    __device__ __forceinline__ void prefetch(Pre& p, const Unit& u, int wr, int fr) const { prefetch_rss(p, rss, u.pm * BM + wr * 64 + fr); }
    __device__ __forceinline__ void operator()(const f32x4 (&acc)[2][2][4][2], const Unit& u, int wr, int wc, int fr, int fq, Pre& pre) const {
        const int row0 = u.pm * BM + wr * 64 + fr, col0 = u.pn * BM + wc * 32 + 8 * fq;
        float rs[2][4]; load_rstd(pre, rs);
#pragma unroll
        for (int ai = 0; ai < 2; ++ai)
#pragma unroll
            for (int m = 0; m < 4; ++m) { unsigned char* rowp = O + (size_t)(row0 + ai * HALF + m * 16) * ldc + col0;
#pragma unroll
                for (int bj = 0; bj < 2; ++bj) { f32x4 v0 = acc[ai][bj][m][0] * rs[ai][m], v1 = acc[ai][bj][m][1] * rs[ai][m];
#pragma unroll
                    for (int j = 0; j < 4; ++j) { const float a = fmaxf(v0[j], 0.f), b = fmaxf(v1[j], 0.f); v0[j] = fminf(a * a, F8_MAX); v1[j] = fminf(b * b, F8_MAX); }
                    u32x2 w; w.x = pk4_fp8(v0[0], v0[1], v0[2], v0[3]); w.y = pk4_fp8(v1[0], v1[1], v1[2], v1[3]);
                    *(u32x2*)(rowp + bj * HALF) = w; } }
    }
};
struct EpiNull {
    static constexpr bool PERM = true, AFTER_DRAIN = false;
    bf16_t* O;
    typedef PreNone Pre;
    __device__ __forceinline__ void prefetch(Pre&, const Unit&, int, int) const {}
    __device__ __forceinline__ void operator()(const f32x4 (&acc)[2][2][4][2], const Unit& u, int wr, int wc, int fr, int fq, Pre&) const {
        float s = 0.f;
#pragma unroll
        for (int ai = 0; ai < 2; ++ai)
#pragma unroll
            for (int bj = 0; bj < 2; ++bj)
#pragma unroll
                for (int m = 0; m < 4; ++m)
#pragma unroll
                    for (int n = 0; n < 2; ++n) s += (acc[ai][bj][m][n][0] + acc[ai][bj][m][n][1]) + (acc[ai][bj][m][n][2] + acc[ai][bj][m][n][3]);
        if (s == 1.2345678e30f) O[(size_t)(u.pm * BM + wr * 64 + fr) * 8192 + u.pn * BM + wc * 32 + 8 * fq] = (bf16_t)1;
    }
};
template <bool LAST, bool H8 = false> struct EpiResBf16 {
    static constexpr bool PERM = true, AFTER_DRAIN = false;
    bf16_t* hb; int ldc; unsigned long long* rss_out; float* out; unsigned char* h8 = nullptr;
    typedef PreNone Pre;
    __device__ __forceinline__ void prefetch(Pre&, const Unit&, int, int) const {}
    __device__ __forceinline__ void operator()(const f32x4 (&acc)[2][2][4][2], const Unit& u, int wr, int wc, int fr, int fq, Pre&) const {
        const int row0 = u.pm * BM + wr * 64 + fr, col0 = u.pn * BM + wc * 32 + 8 * fq;
#pragma unroll
        for (int ai = 0; ai < 2; ++ai)
#pragma unroll
            for (int m = 0; m < 4; ++m) { const int row = row0 + ai * HALF + m * 16; const size_t off = (size_t)row * ldc + col0; float ss = 0.f;
#pragma unroll
                for (int bj = 0; bj < 2; ++bj) { const u32x4 r = *(const u32x4*)(hb + off + bj * HALF);
                    f32x4 o0 = acc[ai][bj][m][0], o1 = acc[ai][bj][m][1];
                    o0[0] += __builtin_bit_cast(float, r.x << 16); o0[1] += __builtin_bit_cast(float, r.x & 0xffff0000u); o0[2] += __builtin_bit_cast(float, r.y << 16); o0[3] += __builtin_bit_cast(float, r.y & 0xffff0000u);
                    o1[0] += __builtin_bit_cast(float, r.z << 16); o1[1] += __builtin_bit_cast(float, r.z & 0xffff0000u); o1[2] += __builtin_bit_cast(float, r.w << 16); o1[3] += __builtin_bit_cast(float, r.w & 0xffff0000u);
                    if (LAST) { *(f32x4*)(out + off + bj * HALF) = o0; *(f32x4*)(out + off + bj * HALF + 4) = o1; ss += (o0[0] * o0[0] + o0[1] * o0[1]) + (o0[2] * o0[2] + o0[3] * o0[3]) + (o1[0] * o1[0] + o1[1] * o1[1]) + (o1[2] * o1[2] + o1[3] * o1[3]); }
                    else { u32x4 w; w.x = cvt_pk_bf16(o0[0], o0[1]); w.y = cvt_pk_bf16(o0[2], o0[3]); w.z = cvt_pk_bf16(o1[0], o1[1]); w.w = cvt_pk_bf16(o1[2], o1[3]); store16_wt(hb + off + bj * HALF, w);
                        const float q0 = __builtin_bit_cast(float, w.x << 16), q1 = __builtin_bit_cast(float, w.x & 0xffff0000u), q2 = __builtin_bit_cast(float, w.y << 16), q3 = __builtin_bit_cast(float, w.y & 0xffff0000u);
                        const float q4 = __builtin_bit_cast(float, w.z << 16), q5 = __builtin_bit_cast(float, w.z & 0xffff0000u), q6 = __builtin_bit_cast(float, w.w << 16), q7 = __builtin_bit_cast(float, w.w & 0xffff0000u);
                        ss += (q0 * q0 + q1 * q1) + (q2 * q2 + q3 * q3) + (q4 * q4 + q5 * q5) + (q6 * q6 + q7 * q7);
                        if constexpr (H8) { u32x2 w8; w8.x = pk4_fp8(fminf(fmaxf(q0, -F8_MAX), F8_MAX), fminf(fmaxf(q1, -F8_MAX), F8_MAX), fminf(fmaxf(q2, -F8_MAX), F8_MAX), fminf(fmaxf(q3, -F8_MAX), F8_MAX));
                            w8.y = pk4_fp8(fminf(fmaxf(q4, -F8_MAX), F8_MAX), fminf(fmaxf(q5, -F8_MAX), F8_MAX), fminf(fmaxf(q6, -F8_MAX), F8_MAX), fminf(fmaxf(q7, -F8_MAX), F8_MAX));
                            *(u32x2*)(h8 + off + bj * HALF) = w8; } } }
                ss += __shfl_xor(ss, 16); ss += __shfl_xor(ss, 32);
                if (fq == 0) atomicAdd(rss_out + row, (unsigned long long)(ss * RSS_SCALE + 0.5f)); }
    }
};
template <class Epi, class Sched, bool ALIGN_EPI = false, bool SP2 = false, bool F8 = false>
__device__ __forceinline__ void gemm_phase(PG8_LAS unsigned char* lds, const Gemm g, const Sched& S, const Epi& E) {
    int tid_ = threadIdx.x; asm volatile("" : "+v"(tid_));
    const int tid = tid_, wid = __builtin_amdgcn_readfirstlane(tid >> 6), lane = tid & 63, wr = wid >> 2, wc = wid & 3, fr = lane & 15, fq = lane >> 4;
    const int K = g.K, KB = F8 ? K : 2 * K  , nt = KB / (BK * 2);
    unsigned voffA[2], voffB[2];
#pragma unroll
    for (int i = 0; i < 2; ++i) { int R, C; stage_rc(tid * 16 + i * 8192, R, C); const int Rb = Epi::PERM ? ((R & ~31) + perm32(R & 31)) : R;
        voffA[i] = (unsigned)(R * KB + C * 2); voffB[i] = (unsigned)(Rb * KB + C * 2); }
    const size_t kstep = (size_t)(BK * 2);
    const size_t hstep = (size_t)HALF * KB;
    const size_t tstep = 2 * hstep;
    const unsigned ldsw = (unsigned)wid * 1024u;
    const int aoff = lds_byte(wr * 64 + fr, fq * 8), boff = lds_byte(wc * 32 + fr, fq * 8);
#define PG8_SA(b, h) (((b) * 2 + (h)) * HTB)
#define PG8_SB(b, h) ((4 + (b) * 2 + (h)) * HTB)
#define PG8_STAGE(bufoff, gbase, voff) do { _Pragma("unroll") for (int _i = 0; _i < 2; ++_i) \
        __builtin_amdgcn_global_load_lds((const unsigned*)((const char*)(gbase) + (voff)[_i]), (PG8_LAS unsigned*)(lds + (bufoff) + ldsw + _i * 8192), 16, 0, 0); } while (0)
#define PG8_LDA(dst, b, h) do { _Pragma("unroll") for (int m = 0; m < 4; ++m) _Pragma("unroll") for (int k = 0; k < 2; ++k) dst[m][k] = *(const PG8_LAS bf16x8*)(lds + PG8_SA(b, h) + aoff + m * 2048 + k * 1024); } while (0)
#define PG8_LDB(dst, b, h) do { _Pragma("unroll") for (int n = 0; n < 2; ++n) _Pragma("unroll") for (int k = 0; k < 2; ++k) dst[n][k] = *(const PG8_LAS bf16x8*)(lds + PG8_SB(b, h) + boff + n * 2048 + k * 1024); } while (0)
#define PG8_MMA(ai, bj, At, Bt) do { __builtin_amdgcn_s_setprio(1); _Pragma("unroll") for (int m = 0; m < 4; ++m) _Pragma("unroll") for (int n = 0; n < 2; ++n) { \
        if constexpr (F8) mfma_f8_acc(acc[ai][bj][m][n], cat_f8(Bt[n][0], Bt[n][1]), cat_f8(At[m][0], At[m][1]), f8_sc); \
        else { _Pragma("unroll") for (int k = 0; k < 2; ++k) acc[ai][bj][m][n] = __builtin_amdgcn_mfma_f32_16x16x32_bf16(Bt[n][k], At[m][k], acc[ai][bj][m][n], 0, 0, 0); } } \
        __builtin_amdgcn_s_setprio(0); } while (0)
#define PG8_WAIT_V(n) asm volatile("s_waitcnt vmcnt(" #n ")" ::: "memory")
#define PG8_WAIT_L(n) asm volatile("s_waitcnt lgkmcnt(" #n ")" ::: "memory")
#define PG8_BAR __builtin_amdgcn_s_barrier()
#define PG8_SCHED __builtin_amdgcn_sched_barrier(0)
    Unit cur, nxt; int ui = 0;
    if (!S.next(0, cur)) return;
    f32x4 acc[2][2][4][2];
#pragma unroll
    for (int a = 0; a < 2; ++a)
#pragma unroll
        for (int b = 0; b < 2; ++b)
#pragma unroll
            for (int m = 0; m < 4; ++m)
#pragma unroll
                for (int n = 0; n < 2; ++n) acc[a][b][m][n] = (f32x4){0.f, 0.f, 0.f, 0.f};
    bf16x8 At[4][2], B0[2][2], B1[2][2];
    int f8_sc = g.wscale | (127 << 8); if constexpr (F8) asm volatile("" : "+v"(f8_sc));
    typename Epi::Pre pre;
    const char* cA = (const char*)g.A + (size_t)cur.pm * tstep; const char* cB = (const char*)g.Bt + (size_t)cur.pn * tstep;
    S.a_ready(cur);
    if constexpr (SP2) {
        PG8_STAGE(PG8_SB(0, 0), cB, voffB); PG8_STAGE(PG8_SB(0, 1), cB + hstep, voffB); PG8_STAGE(PG8_SA(0, 0), cA, voffA); PG8_STAGE(PG8_SA(0, 1), cA + hstep, voffA);
        if (wr == 1) PG8_BAR;
        PG8_WAIT_V(2); PG8_BAR;
        PG8_STAGE(PG8_SB(1, 0), cB + kstep, voffB); PG8_STAGE(PG8_SA(1, 0), cA + kstep, voffA); PG8_STAGE(PG8_SB(1, 1), cB + hstep + kstep, voffB);
        PG8_WAIT_V(6); PG8_BAR;
    } else {
        PG8_STAGE(PG8_SB(0, 0), cB, voffB); PG8_STAGE(PG8_SA(0, 0), cA, voffA); PG8_STAGE(PG8_SB(0, 1), cB + hstep, voffB); PG8_STAGE(PG8_SA(0, 1), cA + hstep, voffA);
        if (wr == 1) PG8_BAR;
        PG8_WAIT_V(4); PG8_BAR;
        PG8_STAGE(PG8_SB(1, 0), cB + kstep, voffB); PG8_STAGE(PG8_SA(1, 0), cA + kstep, voffA); PG8_STAGE(PG8_SB(1, 1), cB + hstep + kstep, voffB);
        PG8_WAIT_V(6); PG8_BAR;
    }
    for (;;) {
        const bool has_next = S.next(ui + 1, nxt);
        const char* nA = has_next ? (const char*)g.A + (size_t)nxt.pm * tstep : cA; const char* nB = has_next ? (const char*)g.Bt + (size_t)nxt.pn * tstep : cB;
        for (int t = 0; t < nt; t += 2) {
            const bool last = (t == nt - 2);
            const char* a1 = cA + (size_t)(t + 1) * kstep;
            const char* a2 = last ? nA : cA + (size_t)(t + 2) * kstep; const char* b2 = last ? nB : cB + (size_t)(t + 2) * kstep;
            const char* a3 = a2 + kstep; const char* b3 = b2 + kstep;
            if (last && has_next) S.a_ready(nxt);
            if (last) E.prefetch(pre, cur, wr, fr);
            if constexpr (SP2) {
            PG8_LDB(B0, 0, 0); PG8_LDB(B1, 0, 1); PG8_SCHED; PG8_LDA(At, 0, 0); PG8_STAGE(PG8_SA(1, 1), a1 + hstep, voffA);
            PG8_WAIT_V(8); PG8_WAIT_L(0); PG8_BAR; PG8_MMA(0, 0, At, B0); PG8_MMA(0, 1, At, B1); PG8_BAR; PG8_SCHED;
            PG8_LDA(At, 0, 1); PG8_STAGE(PG8_SB(0, 0), b2, voffB); PG8_STAGE(PG8_SB(0, 1), b2 + hstep, voffB); PG8_STAGE(PG8_SA(0, 0), a2, voffA);
            PG8_WAIT_V(8); PG8_WAIT_L(0); PG8_BAR; PG8_MMA(1, 0, At, B0); PG8_MMA(1, 1, At, B1); PG8_BAR; PG8_SCHED;
            PG8_LDB(B0, 1, 0); PG8_LDB(B1, 1, 1); PG8_SCHED; PG8_LDA(At, 1, 0); PG8_STAGE(PG8_SA(0, 1), a2 + hstep, voffA);
            PG8_WAIT_V(8); PG8_WAIT_L(0); PG8_BAR; PG8_MMA(0, 0, At, B0); PG8_MMA(0, 1, At, B1); PG8_BAR; PG8_SCHED;
            PG8_LDA(At, 1, 1); PG8_STAGE(PG8_SB(1, 0), b3, voffB); PG8_STAGE(PG8_SB(1, 1), b3 + hstep, voffB); PG8_STAGE(PG8_SA(1, 0), a3, voffA);
            PG8_WAIT_V(8); PG8_WAIT_L(0); PG8_BAR; PG8_MMA(1, 0, At, B0); PG8_MMA(1, 1, At, B1); PG8_BAR; PG8_SCHED;
            } else {
            PG8_LDB(B0, 0, 0); PG8_SCHED; PG8_LDA(At, 0, 0); PG8_STAGE(PG8_SA(1, 1), a1 + hstep, voffA);
            PG8_WAIT_L(8); PG8_BAR; PG8_WAIT_L(0); PG8_MMA(0, 0, At, B0); PG8_BAR; PG8_SCHED;
            PG8_LDB(B1, 0, 1); PG8_STAGE(PG8_SB(0, 0), b2, voffB);
            PG8_BAR; PG8_WAIT_L(0); PG8_MMA(0, 1, At, B1); PG8_BAR;
            PG8_LDA(At, 0, 1); PG8_STAGE(PG8_SA(0, 0), a2, voffA);
            PG8_BAR; PG8_WAIT_L(0); PG8_MMA(1, 0, At, B0); PG8_BAR; PG8_SCHED;
            PG8_STAGE(PG8_SB(0, 1), b2 + hstep, voffB);
            PG8_WAIT_V(6); PG8_BAR; PG8_MMA(1, 1, At, B1); PG8_BAR;
            PG8_LDB(B0, 1, 0); PG8_SCHED; PG8_LDA(At, 1, 0); PG8_STAGE(PG8_SA(0, 1), a2 + hstep, voffA);
            PG8_WAIT_L(8); PG8_BAR; PG8_WAIT_L(0); PG8_MMA(0, 0, At, B0); PG8_BAR; PG8_SCHED;
            PG8_LDB(B1, 1, 1); PG8_STAGE(PG8_SB(1, 0), b3, voffB);
            PG8_BAR; PG8_WAIT_L(0); PG8_MMA(0, 1, At, B1); PG8_BAR;
            PG8_LDA(At, 1, 1); PG8_STAGE(PG8_SA(1, 0), a3, voffA);
            PG8_BAR; PG8_WAIT_L(0); PG8_MMA(1, 0, At, B0); PG8_BAR; PG8_SCHED;
            PG8_STAGE(PG8_SB(1, 1), b3 + hstep, voffB);
            PG8_WAIT_V(6); PG8_BAR; PG8_MMA(1, 1, At, B1); PG8_BAR;
            }
        }
        if constexpr (F8) asm volatile("s_nop 15\n\ts_nop 7" ::: "memory");
        if constexpr (ALIGN_EPI) { if (wr == 0) PG8_BAR; }
        if constexpr (!Epi::AFTER_DRAIN) { E(acc, cur, wr, wc, fr, fq, pre); S.done(cur); }
        if (!has_next) break;
#pragma unroll
        for (int a = 0; a < 2; ++a)
#pragma unroll
            for (int b = 0; b < 2; ++b)
#pragma unroll
                for (int m = 0; m < 4; ++m)
#pragma unroll
                    for (int n = 0; n < 2; ++n) acc[a][b][m][n] = (f32x4){0.f, 0.f, 0.f, 0.f};
        cur = nxt; cA = nA; cB = nB; ++ui;
        if constexpr (ALIGN_EPI) { if (wr == 1) PG8_BAR; }
    }
    PG8_WAIT_V(0);
    if constexpr (!ALIGN_EPI) { if (wr == 0) PG8_BAR; }
    PG8_BAR;
    if constexpr (Epi::AFTER_DRAIN) { E.fused(acc, cur, wr, wc, fr, fq, lds, wid, lane); S.done(cur); }
#undef PG8_SA
#undef PG8_SB
#undef PG8_STAGE
#undef PG8_LDA
#undef PG8_LDB
#undef PG8_MMA
#undef PG8_WAIT_V
#undef PG8_WAIT_L
#undef PG8_BAR
#undef PG8_SCHED
}
}

constexpr int BATCH = 4, SEQ = 4096, D = 2048, M = BATCH * SEQ, FF = 8192, DEPTH = 4;
constexpr int AB_IN = 5136, NP_E = 5376;
constexpr int C_IN = 4176, NP_O = 4352;
constexpr int KSEL = 256;
constexpr float EPS = 1e-6f;
constexpr int EC_U = 0, EC_V = 1024, EC_Q = 2048, EC_K = 2560, EC_VV = 3072, EC_R = 4096, EC_G = 5120;
constexpr int OC_Q = 0, OC_K = 2048, OC_V = 2560, OC_IQ = 3072, OC_IK = 4096, OC_IW = 4160;

constexpr size_t MiB = 1u << 20;
constexpr size_t WS_CTL = 0, CTL_ZERO_BYTES = 2 * MiB;
constexpr size_t WS_RSS = 768 * 1024;
constexpr size_t WS_KMAX = 1920 * 1024;
constexpr size_t WS_WABIN = 2 * MiB;
constexpr size_t WS_WABOUT = WS_WABIN + 42 * MiB;
constexpr size_t WS_WCIN = WS_WABOUT + 16 * MiB;
constexpr size_t WS_WCOUT = WS_WCIN + 34 * MiB;
constexpr size_t WS_WF1 = WS_WCOUT + 16 * MiB;
constexpr size_t WS_WF2 = WS_WF1 + 128 * MiB;
constexpr size_t WS_HB = WS_WF2 + 128 * MiB;
constexpr size_t WS_AB = WS_HB + 64 * MiB;
constexpr size_t WS_P = WS_AB + 64 * MiB;
constexpr size_t WS_IDX = WS_P + 256 * MiB;
constexpr size_t WS_CNT = WS_IDX + 16 * MiB;
constexpr size_t WS_QE = WS_CNT + 1 * MiB;
constexpr size_t WS_KE = WS_QE + 16 * MiB;
constexpr size_t WS_DS = WS_KE + 16 * MiB;
constexpr size_t WS_SP = WS_DS + 32 * MiB;
constexpr size_t WS_LAST = WS_SP + 16 * MiB;
constexpr size_t WS_MASK = WS_LAST + 1 * MiB;
constexpr size_t WS_WSB = WS_MASK + 8 * MiB;
constexpr size_t WS_END = WS_WSB + 1 * MiB;
constexpr int CW_BAR = 4096;

constexpr int PH_LDS = 155648;
constexpr int LDSCTL_OFF = PH_LDS;
constexpr int LDS_BYTES = PH_LDS + 512;
constexpr int NWAVES = 8;

#define GAS __attribute__((address_space(1)))
#define LAS __attribute__((address_space(3)))
typedef unsigned short bf16;
typedef unsigned v4u __attribute__((ext_vector_type(4)));
typedef unsigned v2u __attribute__((ext_vector_type(2)));
typedef float f32x4 __attribute__((ext_vector_type(4)));
typedef __bf16 bf16x2_t __attribute__((ext_vector_type(2)));
typedef GAS unsigned gu32;
#define RLX_AGENT __ATOMIC_RELAXED, __HIP_MEMORY_SCOPE_AGENT
#define LDS_WAIT() asm volatile("s_waitcnt lgkmcnt(0)" ::: "memory")
#define VM_WAIT() asm volatile("s_waitcnt vmcnt(0)" ::: "memory")
__device__ __forceinline__ unsigned f2bf(float f) { unsigned u = __builtin_bit_cast(unsigned, f); return (u + 0x7fffu + ((u >> 16) & 1u)) >> 16; }
__device__ __forceinline__ unsigned pk2(float lo, float hi) { return f2bf(lo) | (f2bf(hi) << 16); }
__device__ __forceinline__ float bf_lo(unsigned w) { return __builtin_bit_cast(float, w << 16); }
__device__ __forceinline__ float bf_hi(unsigned w) { return __builtin_bit_cast(float, w & 0xffff0000u); }
__device__ __forceinline__ float bf2f(bf16 b) { return __builtin_bit_cast(float, ((unsigned)b) << 16); }
__device__ __forceinline__ float dot2bf(unsigned a, unsigned b, float c) { return __builtin_amdgcn_fdot2_f32_bf16(__builtin_bit_cast(bf16x2_t, a), __builtin_bit_cast(bf16x2_t, b), c, false); }
__device__ __forceinline__ float wave_sum(float v) {
#pragma unroll
    for (int o = 1; o < 64; o <<= 1) v += __shfl_xor(v, o);
    return v;
}
__device__ __forceinline__ float wave_max(float v) {
#pragma unroll
    for (int o = 1; o < 64; o <<= 1) v = fmaxf(v, __shfl_xor(v, o));
    return v;
}
__device__ __forceinline__ int half_sum_i(int v) {
    v += __builtin_amdgcn_ds_swizzle(v, 0x041F); v += __builtin_amdgcn_ds_swizzle(v, 0x081F); v += __builtin_amdgcn_ds_swizzle(v, 0x101F); v += __builtin_amdgcn_ds_swizzle(v, 0x201F); v += __builtin_amdgcn_ds_swizzle(v, 0x401F);
    return v;
}
__device__ __forceinline__ int half_sum_dpp(int v, int hh) {
    v += __builtin_amdgcn_update_dpp(0, v, 0x111, 0xf, 0xf, true);
    v += __builtin_amdgcn_update_dpp(0, v, 0x112, 0xf, 0xf, true);
    v += __builtin_amdgcn_update_dpp(0, v, 0x114, 0xf, 0xf, true);
    v += __builtin_amdgcn_update_dpp(0, v, 0x118, 0xf, 0xf, true);
    v += __builtin_amdgcn_update_dpp(0, v, 0x142, 0xa, 0xf, true);
    const int t0 = __builtin_amdgcn_readlane(v, 31), t1 = __builtin_amdgcn_readlane(v, 63);
    return hh ? t1 : t0;
}
#define WRITELANE(vreg, sval, lane_imm) asm volatile("s_nop 3\n\tv_writelane_b32 %0, %1, %2" : "+v"(vreg) : "s"(sval), "n"(lane_imm))
__device__ __forceinline__ int wave_sum_i(int v) {
#pragma unroll
    for (int o = 1; o < 64; o <<= 1) v += __shfl_xor(v, o);
    return v;
}
typedef short bf16x8 __attribute__((ext_vector_type(8)));
typedef short s16x4 __attribute__((ext_vector_type(4)));
typedef short v4i16_t __attribute__((ext_vector_type(4)));
typedef float f32x16 __attribute__((ext_vector_type(16)));
typedef float f32x2_t __attribute__((ext_vector_type(2)));
__device__ __forceinline__ unsigned cvtpk(float lo, float hi) { f32x2_t v = {lo, hi}; bf16x2_t b = __builtin_convertvector(v, bf16x2_t); return __builtin_bit_cast(unsigned, b); }
__device__ __forceinline__ s16x4 tr16(const LAS unsigned char* p) { return __builtin_bit_cast(s16x4, __builtin_amdgcn_ds_read_tr16_b64_v4i16((LAS v4i16_t*)p)); }
__device__ __forceinline__ bf16x8 ldsb128(const LAS unsigned char* p) { return *(const LAS bf16x8*)p; }
__device__ __forceinline__ bf16x8 cat8(s16x4 lo, s16x4 hi) { return __builtin_shufflevector(lo, hi, 0, 1, 2, 3, 4, 5, 6, 7); }
__device__ __forceinline__ bf16x8 pack8(const f32x16& x, int s) { v4u p; p.x = cvtpk(x[8 * s + 0], x[8 * s + 1]); p.y = cvtpk(x[8 * s + 2], x[8 * s + 3]); p.z = cvtpk(x[8 * s + 4], x[8 * s + 5]); p.w = cvtpk(x[8 * s + 6], x[8 * s + 7]); return __builtin_bit_cast(bf16x8, p); }
#define MFMA32(a, b, c) __builtin_amdgcn_mfma_f32_32x32x16_bf16((a), (b), (c), 0, 0, 0)
__device__ __forceinline__ int crow(int reg, int h) { return (reg & 3) + 8 * (reg >> 2) + 4 * h; }
__device__ const unsigned char T5B[128] = {0, 1, 2, 3, 4, 5, 6, 7, 8, 9, 10, 11, 12, 13, 14, 15, 16, 16, 16, 17, 17, 18, 18, 18, 19, 19, 19, 20, 20, 20, 20, 21, 21, 21, 21, 22, 22, 22, 22, 22, 23, 23, 23, 23, 23, 23, 24, 24, 24, 24, 24, 24, 25, 25, 25, 25, 25, 25, 25, 26, 26, 26, 26, 26, 26, 26, 26, 27, 27, 27, 27, 27, 27, 27, 27, 27, 27, 28, 28, 28, 28, 28, 28, 28, 28, 28, 28, 29, 29, 29, 29, 29, 29, 29, 29, 29, 29, 29, 29, 30, 30, 30, 30, 30, 30, 30, 30, 30, 30, 30, 30, 30, 30, 31, 31, 31, 31, 31, 31, 31, 31, 31, 31, 31, 31, 31, 31, 31};
__device__ __forceinline__ int t5_bucket(int dist) { return dist >= 128 ? 31 : (int)T5B[dist]; }

#define XB_TMO      128
#define XB_XCNT(j)  (256  + 64 * (j))
#define XB_XSUB(j)  (1280 + 64 * (j))
#define XB_XGEN(j)  (2304 + 64 * (j))
#define XB_TOP      3328
#define XB_TOPGEN   3392
#define XCD_BAR_WORDS 3456
#define XB_SPIN_CAP (1u << 18)

__device__ __forceinline__ unsigned xb_ld(unsigned* p)              { return __hip_atomic_load(p, __ATOMIC_RELAXED, __HIP_MEMORY_SCOPE_AGENT); }
__device__ __forceinline__ unsigned xb_add(unsigned* p, unsigned v) { return __hip_atomic_fetch_add(p, v, __ATOMIC_RELAXED, __HIP_MEMORY_SCOPE_AGENT); }
__device__ __forceinline__ unsigned xb_xcc_id() { return (unsigned)__builtin_amdgcn_s_getreg((3 << 11) | 20) & 0xFu; }
#define XB_SPIN(cond, bar) do { unsigned _sp = 0; while (cond) { __builtin_amdgcn_s_sleep(1); \
    if ((++_sp & 255u) == 0u) { if (xb_ld(&(bar)[XB_TMO])) break; if (_sp > XB_SPIN_CAP) { atomicAdd(&(bar)[XB_TMO], 1u); break; } } } } while (0)

struct XcdBarrier {
    unsigned* bar; unsigned x;
    volatile LAS unsigned* st;
};

__device__ __forceinline__ XcdBarrier xcd_barrier_post(unsigned* bar, volatile LAS unsigned* st) {
    XcdBarrier b; b.bar = bar; b.x = xb_xcc_id(); b.st = st;
    if (threadIdx.x == 0) (void)xb_add(&bar[XB_XCNT(b.x)], 1u);
    return b;
}
__device__ __forceinline__ void xcd_barrier_complete(unsigned* bar, unsigned x, unsigned& nloc, unsigned& nx) {
    const unsigned G = gridDim.x * gridDim.y * gridDim.z;
    unsigned sum, cnt, mine, sp = 0u;
    for (;;) {
        sum = 0u; cnt = 0u; mine = 0u;
#pragma unroll
        for (unsigned j = 0; j < 16; ++j) { const unsigned c = xb_ld(&bar[XB_XCNT(j)]); sum += c; cnt += (c > 0u) ? 1u : 0u; mine = (j == x) ? c : mine; }
        if (sum == G) break;
        __builtin_amdgcn_s_sleep(1);
        if ((++sp & 255u) == 0u) { if (xb_ld(&bar[XB_TMO])) break; if (sp > XB_SPIN_CAP) { atomicAdd(&bar[XB_TMO], 1u); break; } }
    }
    nloc = mine > 0u ? mine : 1u; nx = cnt > 0u ? cnt : 1u;
}

__device__ __forceinline__ void xcd_barrier(const XcdBarrier& b) {
    asm volatile("s_waitcnt vmcnt(0)" ::: "memory");
    __syncthreads();
    if (threadIdx.x == 0) {
        unsigned* bar = b.bar;
        __builtin_amdgcn_s_waitcnt(0);
        unsigned nloc = b.st[0], nx = b.st[1];
        if (nloc == 0u) { xcd_barrier_complete(bar, b.x, nloc, nx); b.st[0] = nloc; b.st[1] = nx; }
        const unsigned old = xb_add(&bar[XB_XSUB(b.x)], 1u);
        const unsigned gen = old / nloc;
        if (old + 1u == (gen + 1u) * nloc) {
            __builtin_amdgcn_fence(__ATOMIC_RELEASE, "agent");
            asm volatile("s_waitcnt vmcnt(0)" ::: "memory");
            const unsigned og = xb_add(&bar[XB_TOP], 1u);
            const unsigned tg = og / nx;
            if (og + 1u == (tg + 1u) * nx) xb_add(&bar[XB_TOPGEN], 1u);
            else XB_SPIN(xb_ld(&bar[XB_TOPGEN]) == tg, bar);
            __builtin_amdgcn_fence(__ATOMIC_ACQUIRE, "agent");
            xb_add(&bar[XB_XGEN(b.x)], 1u);
            asm volatile("s_waitcnt vmcnt(0)" ::: "memory");
        } else {
            XB_SPIN(xb_ld(&bar[XB_XGEN(b.x)]) == gen, bar);
            __builtin_amdgcn_fence(__ATOMIC_ACQUIRE, "agent");
            asm volatile("s_waitcnt vmcnt(0)" ::: "memory");
        }
    }
    __syncthreads();
}

struct Frame {
    LAS unsigned char* lds;
    volatile LAS unsigned* MISC;
    gu32* ctl;
    int G;
    __device__ __forceinline__ int tid_() const { int t = (int)threadIdx.x; asm volatile("" : "+v"(t)); return t; }
    __device__ __forceinline__ int lane_() const { int t = (int)threadIdx.x; asm volatile("" : "+v"(t)); return t & 63; }
    __device__ __forceinline__ int wave_() const { return __builtin_amdgcn_readfirstlane((int)threadIdx.x >> 6); }
    float* out;
    __device__ __forceinline__ const float* in(int i) const { const volatile LAS unsigned* t = MISC + 32 + 2 * i; const unsigned lo = __builtin_amdgcn_readfirstlane(t[0]), hi = __builtin_amdgcn_readfirstlane(t[1]); return (const float*)(((unsigned long long)hi << 32) | lo); }
    bf16 *Wabin, *Wabout, *Wcin, *Wcout, *Wf1, *Wf2;
    bf16 *HB, *AB, *P;
    unsigned long long* RSS;
    unsigned* KMAX;
    int *IDX, *CNT;
    bf16 *QE, *KE, *SP; float *DS, *LAST; unsigned* MASK; bf16* WSB;
};
enum { I_X = 0, I_NMG, I_NFG, I_FNG, I_ABWIN, I_AVLNG, I_AWS, I_ABS, I_BGW2, I_BGB, I_BONG, I_ABWOUT, I_CWIN, I_CWOUT, I_RELB, I_FW1, I_FW2 };

__device__ __forceinline__ void transpose_load(const float* W, int K, int N, int item, int nblk, int lane, const float* gain, f32x4 (&v)[8]) {
    const int kb = item / nblk, nb = item - kb * nblk, k0 = 64 * kb + 8 * (lane >> 3), n0 = 32 * nb + 4 * (lane & 7);
    if (n0 < N) {
#pragma unroll
        for (int i = 0; i < 8; ++i) v[i] = __builtin_nontemporal_load((const f32x4*)(W + (size_t)(k0 + i) * N + n0));
        if (gain) { const f32x4 g0 = *(const f32x4*)(gain + k0), g1 = *(const f32x4*)(gain + k0 + 4);
            v[0] = v[0] * g0.x; v[1] = v[1] * g0.y; v[2] = v[2] * g0.z; v[3] = v[3] * g0.w; v[4] = v[4] * g1.x; v[5] = v[5] * g1.y; v[6] = v[6] * g1.z; v[7] = v[7] * g1.w; }
    } else {
#pragma unroll
        for (int i = 0; i < 8; ++i) v[i] = (f32x4){0.f, 0.f, 0.f, 0.f};
    }
}
__device__ __forceinline__ void transpose_store(const f32x4 (&v)[8], int K, bf16* WT, int item, int nblk, int lane) {
    const int kb = item / nblk, nb = item - kb * nblk, k0 = 64 * kb + 8 * (lane >> 3), n0 = 32 * nb + 4 * (lane & 7);
    v4u o0, o1, o2, o3;
    o0.x = cvtpk(v[0].x, v[1].x); o0.y = cvtpk(v[2].x, v[3].x); o0.z = cvtpk(v[4].x, v[5].x); o0.w = cvtpk(v[6].x, v[7].x);
    o1.x = cvtpk(v[0].y, v[1].y); o1.y = cvtpk(v[2].y, v[3].y); o1.z = cvtpk(v[4].y, v[5].y); o1.w = cvtpk(v[6].y, v[7].y);
    o2.x = cvtpk(v[0].z, v[1].z); o2.y = cvtpk(v[2].z, v[3].z); o2.z = cvtpk(v[4].z, v[5].z); o2.w = cvtpk(v[6].z, v[7].z);
    o3.x = cvtpk(v[0].w, v[1].w); o3.y = cvtpk(v[2].w, v[3].w); o3.z = cvtpk(v[4].w, v[5].w); o3.w = cvtpk(v[6].w, v[7].w);
    bf16* op = WT + (size_t)n0 * K + k0;
    *(v4u*)op = o0; *(v4u*)(op + K) = o1; *(v4u*)(op + 2 * (size_t)K) = o2; *(v4u*)(op + 3 * (size_t)K) = o3;
}
__device__ __forceinline__ void transpose_store_f8(const f32x4 (&v)[8], int K, unsigned char* WT8, int item, int nblk, int lane, float scale) {
    const int kb = item / nblk, nb = item - kb * nblk, k0 = 64 * kb + 8 * (lane >> 3), n0 = 32 * nb + 4 * (lane & 7);
    f32x4 s[8];
#pragma unroll
    for (int i = 0; i < 8; ++i) { s[i] = v[i] * scale;
#pragma unroll
        for (int j = 0; j < 4; ++j) s[i][j] = fminf(fmaxf(s[i][j], -pg8::F8_MAX), pg8::F8_MAX); }
    v2u o0, o1, o2, o3;
    o0.x = pg8::pk4_fp8(s[0].x, s[1].x, s[2].x, s[3].x); o0.y = pg8::pk4_fp8(s[4].x, s[5].x, s[6].x, s[7].x);
    o1.x = pg8::pk4_fp8(s[0].y, s[1].y, s[2].y, s[3].y); o1.y = pg8::pk4_fp8(s[4].y, s[5].y, s[6].y, s[7].y);
    o2.x = pg8::pk4_fp8(s[0].z, s[1].z, s[2].z, s[3].z); o2.y = pg8::pk4_fp8(s[4].z, s[5].z, s[6].z, s[7].z);
    o3.x = pg8::pk4_fp8(s[0].w, s[1].w, s[2].w, s[3].w); o3.y = pg8::pk4_fp8(s[4].w, s[5].w, s[6].w, s[7].w);
    unsigned char* op = WT8 + (size_t)n0 * K + k0;
    *(v2u*)op = o0; *(v2u*)(op + K) = o1; *(v2u*)(op + 2 * (size_t)K) = o2; *(v2u*)(op + 3 * (size_t)K) = o3;
}
#ifndef CONV_DEPTH
#define CONV_DEPTH 4
#endif
#define CONV_LOOP(lo_, hi_, LD, ST) do { \
    _Pragma("unroll 1") for (int it_ = (lo_) + gw; it_ < (hi_); it_ += CONV_DEPTH * NGW) { \
        f32x4 v_[CONV_DEPTH][8]; \
        _Pragma("unroll") for (int j_ = 0; j_ < CONV_DEPTH; ++j_) { const int i2 = it_ + j_ * NGW; if (i2 < (hi_)) { LD(i2, v_[j_]); } } \
        _Pragma("unroll") for (int j_ = 0; j_ < CONV_DEPTH; ++j_) { const int i2 = it_ + j_ * NGW; if (i2 < (hi_)) { ST(i2, v_[j_]); } } \
    } } while (0)
__device__ __forceinline__ bool conv_slot(Frame& F, int part, int& gw, int& ngw) {
    if (part < 0) { gw = blockIdx.x * NWAVES + F.wave_(); ngw = F.G * NWAVES; return true; }
    const int b = (int)blockIdx.x;
    if ((F.G & 15) != 0) { if (part == 0) { gw = b * NWAVES + F.wave_(); ngw = F.G * NWAVES; return true; } return false; }
    if (((b >> 3) & 1) != part) return false;
    gw = (((b >> 4) << 3) | (b & 7)) * NWAVES + F.wave_(); ngw = (F.G >> 1) * NWAVES; return true;
}
__device__ __forceinline__ void convert_inout(Frame& F, int L, int part = -1) {
    int gw, NGW; if (!conv_slot(F, part, gw, NGW)) return;
    const bool all = part < 0 || (F.G & 15) != 0;
    const int lane = F.lane_(), l = L >> 1;
    constexpr int I_ABIN = (D / 64) * (NP_E / 32), I_SQ = (D / 64) * (D / 32), I_CIN = (D / 64) * (NP_O / 32);
    if (!(L & 1)) {
        const int n = I_ABIN + I_SQ, lo = all ? 0 : (part ? n / 2 : 0), hi = all ? n : (part ? n : n / 2);
#define LD_(i2, v) do { if (i2 < I_ABIN) transpose_load(F.in(I_ABWIN) + (size_t)l * D * AB_IN, D, AB_IN, i2, NP_E / 32, lane, F.in(I_NMG) + (size_t)L * D, v); else transpose_load(F.in(I_ABWOUT) + (size_t)l * D * D, D, D, i2 - I_ABIN, D / 32, lane, nullptr, v); } while (0)
#define ST_(i2, v) do { if (i2 < I_ABIN) transpose_store(v, D, F.Wabin + (size_t)l * NP_E * D, i2, NP_E / 32, lane); else transpose_store(v, D, F.Wabout + (size_t)l * D * D, i2 - I_ABIN, D / 32, lane); } while (0)
        CONV_LOOP(lo, hi, LD_, ST_);
#undef LD_
#undef ST_
    } else {
        const int n = I_CIN + I_SQ, lo = all ? 0 : (part ? n / 2 : 0), hi = all ? n : (part ? n : n / 2);
#define LD_(i2, v) do { if (i2 < I_CIN) transpose_load(F.in(I_CWIN) + (size_t)l * D * C_IN, D, C_IN, i2, NP_O / 32, lane, F.in(I_NMG) + (size_t)L * D, v); else transpose_load(F.in(I_CWOUT) + (size_t)l * D * D, D, D, i2 - I_CIN, D / 32, lane, nullptr, v); } while (0)
#define ST_(i2, v) do { if (i2 < I_CIN) transpose_store(v, D, F.Wcin + (size_t)l * NP_O * D, i2, NP_O / 32, lane); else transpose_store(v, D, F.Wcout + (size_t)l * D * D, i2 - I_CIN, D / 32, lane); } while (0)
        CONV_LOOP(lo, hi, LD_, ST_);
#undef LD_
#undef ST_
    }
}
constexpr float W2_F8_SCALE = 1024.f;
constexpr float W1_F8_SCALE = 512.f;
__device__ __forceinline__ void convert_ffn(Frame& F, int L, int part = -1, bool w2_f8 = false, bool w1_f8 = false) {
    int gw, NGW; if (!conv_slot(F, part, gw, NGW)) return;
    const bool all = part < 0 || (F.G & 15) != 0;
    const int lane = F.lane_();
    constexpr int I_F = (D / 64) * (FF / 32);
    const int lo = all ? 0 : (part ? I_F : 0), hi = all ? 2 * I_F : (part ? 2 * I_F : I_F);
#define LD_(i2, v) do { if (i2 < I_F) transpose_load(F.in(I_FW1) + (size_t)L * D * FF, D, FF, i2, FF / 32, lane, F.in(I_NFG) + (size_t)L * D, v); else transpose_load(F.in(I_FW2) + (size_t)L * FF * D, FF, D, i2 - I_F, D / 32, lane, nullptr, v); } while (0)
#define ST_(i2, v) do { if (i2 < I_F) { if (w1_f8) transpose_store_f8(v, D, (unsigned char*)(F.Wf1 + (size_t)L * FF * D), i2, FF / 32, lane, W1_F8_SCALE); else transpose_store(v, D, F.Wf1 + (size_t)L * FF * D, i2, FF / 32, lane); } else if (w2_f8) transpose_store_f8(v, FF, (unsigned char*)(F.Wf2 + (size_t)L * D * FF), i2 - I_F, D / 32, lane, W2_F8_SCALE); else transpose_store(v, FF, F.Wf2 + (size_t)L * D * FF, i2 - I_F, D / 32, lane); } while (0)
    CONV_LOOP(lo, hi, LD_, ST_);
#undef LD_
#undef ST_
}
#ifndef JIT_WEIGHTS
#define JIT_WEIGHTS 1
#endif
__device__ __forceinline__ void p0_prologue(Frame& F) {
    const int gw = blockIdx.x * NWAVES + F.wave_(), NGW = F.G * NWAVES, lane = F.lane_();
    { const float* ws_ = F.in(I_AWS);
      for (int i = (int)blockIdx.x * 512 + F.tid_(); i < 2 * 8 * 128 * 128; i += F.G * 512) { const int s = i & 127, t = (i >> 7) & 127; F.WSB[i] = (bf16)((s <= t) ? f2bf(ws_[i]) : 0u); } }
#if JIT_WEIGHTS
    convert_inout(F, 0);
#else
#pragma unroll 1
    for (int L = 0; L < DEPTH; ++L) { convert_inout(F, L); convert_ffn(F, L); }
#endif
    { const float* x = F.in(I_X);
      for (int m = gw; m < M; m += NGW) {
          const f32x4* xr = (const f32x4*)(x + (size_t)m * D) + lane; float ss = 0.f;
#pragma unroll
          for (int jj = 0; jj < 8; ++jj) { const f32x4 v = xr[64 * jj]; ss += (v.x * v.x + v.y * v.y) + (v.z * v.z + v.w * v.w); v2u wv; wv.x = cvtpk(v.x, v.y); wv.y = cvtpk(v.z, v.w); ((v2u*)(F.HB + (size_t)m * D))[lane + 64 * jj] = wv; }
          ss = wave_sum(ss);
          if (lane == 0) F.RSS[m] = (unsigned long long)(ss * 65536.f + 0.5f);
      } }
}

__device__ __forceinline__ void final_norm_phase(Frame& F, const float* g, const unsigned long long* rss, const bf16* hb, float* out) {
    const int gw = blockIdx.x * NWAVES + F.wave_(), NGW = F.G * NWAVES, lane = F.lane_();
    for (int m = gw; m < M; m += NGW) {
        const float rstd = rsqrtf((float)rss[m] * (1.f / (65536.f * 2048.f)) + EPS);
        const v4u* hr = (const v4u*)(hb + (size_t)m * D) + lane; f32x4* orow = (f32x4*)(out + (size_t)m * D);
#pragma unroll
        for (int j = 0; j < 4; ++j) { const v4u w = hr[64 * j]; const f32x4 g0 = ((const f32x4*)g)[2 * (lane + 64 * j)], g1 = ((const f32x4*)g)[2 * (lane + 64 * j) + 1];
            const f32x4 a = {bf_lo(w.x) * rstd * g0.x, bf_hi(w.x) * rstd * g0.y, bf_lo(w.y) * rstd * g0.z, bf_hi(w.y) * rstd * g0.w};
            const f32x4 c = {bf_lo(w.z) * rstd * g1.x, bf_hi(w.z) * rstd * g1.y, bf_lo(w.w) * rstd * g1.z, bf_hi(w.w) * rstd * g1.w};
            orow[2 * (lane + 64 * j)] = a; orow[2 * (lane + 64 * j) + 1] = c; }
    }
}

__device__ __forceinline__ void gla_a_unit(Frame& F, int li, int u) {
    const int c = u & 15, h = (u >> 4) & 3, b = u >> 6, t0 = b * SEQ + c * 256;
    const int tid = F.tid_(), lane = F.lane_(), w = F.wave_();
    LAS float* GL = (LAS float*)F.lds;
    LAS float* QT = (LAS float*)(F.lds + 16384);
    LAS unsigned char* KST = F.lds + 18432;
    LAS unsigned char* VIM = F.lds + 18432 + 67584;
    const bf16* Pr = F.P + (size_t)t0 * NP_E;
    { const int row = tid >> 1, hf = tid & 1; const v4u g = *(const v4u*)(Pr + (size_t)row * NP_E + EC_G + 8 * hf);
      const f32x4 a = {bf_lo(g.x), bf_hi(g.x), bf_lo(g.y), bf_hi(g.y)}, a2 = {bf_lo(g.z), bf_hi(g.z), bf_lo(g.w), bf_hi(g.w)};
      *(LAS f32x4*)(GL + row * 16 + 8 * hf) = a; *(LAS f32x4*)(GL + row * 16 + 8 * hf + 4) = a2; }
    const int d = tid & 127, qtr = __builtin_amdgcn_readfirstlane(tid >> 7);
    float gw[16];
    { const float* gw2 = F.in(I_BGW2) + (size_t)li * 16 * 512 + h * 128 + d;
#pragma unroll
      for (int r = 0; r < 16; ++r) gw[r] = gw2[r * 512]; }
    const float gbd = F.in(I_BGB)[(size_t)li * 512 + h * 128 + d];
    v4u vst[4];
#pragma unroll
    for (int i = 0; i < 4; ++i) { const int piece = tid + 512 * i, row = piece >> 5, pc = piece & 31; vst[i] = *(const v4u*)(Pr + (size_t)row * NP_E + EC_VV + h * 256 + pc * 8); }
    __syncthreads();
    float cl[64]; float run = 0.f;
#pragma unroll
    for (int jj = 0; jj < 64; ++jj) {
        const LAS f32x4* g4 = (const LAS f32x4*)(GL + (qtr * 64 + jj) * 16); const f32x4 g0 = g4[0], g1 = g4[1], g2 = g4[2], g3 = g4[3];
        float x = gbd;
        x += g0.x * gw[0]; x += g0.y * gw[1]; x += g0.z * gw[2]; x += g0.w * gw[3]; x += g1.x * gw[4]; x += g1.y * gw[5]; x += g1.z * gw[6]; x += g1.w * gw[7];
        x += g2.x * gw[8]; x += g2.y * gw[9]; x += g2.z * gw[10]; x += g2.w * gw[11]; x += g3.x * gw[12]; x += g3.y * gw[13]; x += g3.z * gw[14]; x += g3.w * gw[15];
        const float ls = fminf(x, 0.f) - __logf(1.f + __expf(-fabsf(x)));
        run += ls * (1.f / 16.f); cl[jj] = run;
    }
    QT[qtr * 128 + d] = run;
    __syncthreads();
    float pre = 0.f, last = 0.f;
#pragma unroll
    for (int q = 0; q < 4; ++q) { const float tq = QT[q * 128 + d]; pre += (q < qtr) ? tq : 0.f; last += tq; }
    const float ref = 0.5f * last, eref = __expf(ref);
    if (qtr == 0) F.LAST[(size_t)u * 128 + d] = last;
    {
        const bf16* qp = Pr + (size_t)(qtr * 64) * NP_E + EC_Q + h * 128 + d; const bf16* kp = Pr + (size_t)(qtr * 64) * NP_E + EC_K + h * 128 + d;
        bf16* qo = F.QE + (size_t)(t0 + qtr * 64) * 512 + h * 128 + d; bf16* ko = F.KE + (size_t)(t0 + qtr * 64) * 512 + h * 128 + d;
#pragma unroll
        for (int j8 = 0; j8 < 8; ++j8) {
            float ks[8];
#pragma unroll
            for (int e = 0; e < 8; ++e) { const int jj = j8 * 8 + e;
                const float e1 = __expf(cl[jj] + pre - ref), e2 = __builtin_amdgcn_rcpf(e1);
                const float qv = bf2f(qp[(size_t)jj * NP_E]), kv = bf2f(kp[(size_t)jj * NP_E]);
                const float ke = kv * e2;
                qo[(size_t)jj * 512] = (bf16)f2bf(qv * 0.08838834764831845f * e1); ko[(size_t)jj * 512] = (bf16)f2bf(ke); ks[e] = ke * eref; }
            v4u pk; pk.x = cvtpk(ks[0], ks[1]); pk.y = cvtpk(ks[2], ks[3]); pk.z = cvtpk(ks[4], ks[5]); pk.w = cvtpk(ks[6], ks[7]);
            *(LAS v4u*)(KST + d * 528 + (qtr * 64 + j8 * 8) * 2) = pk;
        }
    }
    const int vq = w >> 1, dh = w & 1, r = lane & 31, hh = lane >> 5, blk = (lane >> 4) & 1, q4 = (lane >> 2) & 3, p4 = lane & 3;
    f32x16 acc[2][2];
#pragma unroll
    for (int a = 0; a < 2; ++a)
#pragma unroll
        for (int e = 0; e < 2; ++e)
#pragma unroll
            for (int i = 0; i < 16; ++i) acc[a][e][i] = 0.f;
#pragma unroll 1
    for (int jb = 0; jb < 4; ++jb) {
#pragma unroll
        for (int i = 0; i < 4; ++i) { const int piece = tid + 512 * i, row = piece >> 5, pc = piece & 31;
            *(LAS v4u*)(VIM + row * 576 + pc * 16) = vst[i]; }
        if (jb < 3) {
#pragma unroll
            for (int i = 0; i < 4; ++i) { const int piece = tid + 512 * i, row = piece >> 5, pc = piece & 31; vst[i] = *(const v4u*)(Pr + (size_t)(64 * (jb + 1) + row) * NP_E + EC_VV + h * 256 + pc * 8); }
        }
        __syncthreads();
#pragma unroll
        for (int ks = 0; ks < 4; ++ks) {
            bf16x8 A[2], B[2];
#pragma unroll
            for (int vt = 0; vt < 2; ++vt) { const LAS unsigned char* pa = VIM + (16 * ks + 8 * hh + q4) * 576 + (64 * vq + 32 * vt + 16 * blk + 4 * p4) * 2;
                A[vt] = cat8(tr16(pa), tr16(pa + 4 * 576)); }
#pragma unroll
            for (int dt = 0; dt < 2; ++dt) B[dt] = ldsb128(KST + (64 * dh + 32 * dt + r) * 528 + (64 * jb + 16 * ks + 8 * hh) * 2);
#pragma unroll
            for (int vt = 0; vt < 2; ++vt)
#pragma unroll
                for (int dt = 0; dt < 2; ++dt) acc[vt][dt] = MFMA32(A[vt], B[dt], acc[vt][dt]);
        }
        __syncthreads();
    }
    float* dso = F.DS + (size_t)u * 32768;
#pragma unroll
    for (int vt = 0; vt < 2; ++vt)
#pragma unroll
        for (int dt = 0; dt < 2; ++dt)
#pragma unroll
            for (int reg = 0; reg < 16; ++reg) dso[(size_t)(64 * vq + 32 * vt + crow(reg, hh)) * 128 + 64 * dh + 32 * dt + r] = acc[vt][dt][reg];
}
__device__ __forceinline__ void gla_scan(Frame& F) {
    for (int gt = (int)blockIdx.x * 512 + F.tid_(); gt < 131072; gt += F.G * 512) {
        const int bh = gt >> 13, e4 = gt & 8191, d4 = (e4 & 31) * 4;
        f32x4 S = {0.f, 0.f, 0.f, 0.f};
#pragma unroll 4
        for (int c = 0; c < 16; ++c) {
            const int u = bh * 16 + c;
            const f32x4 last = *(const f32x4*)(F.LAST + (size_t)u * 128 + d4);
            const f32x4 er = {__expf(0.5f * last.x), __expf(0.5f * last.y), __expf(0.5f * last.z), __expf(0.5f * last.w)};
            v2u o; o.x = cvtpk(S.x * er.x, S.y * er.y); o.y = cvtpk(S.z * er.z, S.w * er.w);
            *(v2u*)(F.SP + (size_t)u * 32768 + (size_t)e4 * 4) = o;
            if (c < 15) { const f32x4 ds = *(const f32x4*)(F.DS + (size_t)u * 32768 + (size_t)e4 * 4);
                S.x = er.x * er.x * S.x + ds.x; S.y = er.y * er.y * S.y + ds.y; S.z = er.z * er.z * S.z + ds.z; S.w = er.w * er.w * S.w + ds.w; }
        }
    }
}
__device__ __forceinline__ void gla_c_unit(Frame& F, int li, int u) {
    const int c = u & 15, h = (u >> 4) & 3, b = u >> 6, t0 = b * SEQ + c * 256;
    const int tid = F.tid_(), lane = F.lane_(), w = F.wave_();
    const int r = lane & 31, hh = lane >> 5, blk = (lane >> 4) & 1, q4 = (lane >> 2) & 3, p4 = lane & 3, i0 = 32 * w;
    LAS unsigned char* SIM = F.lds;
    LAS unsigned char* KIM = F.lds;
    LAS unsigned char* VIM = F.lds + 17408;
    bf16x8 qf[8];
    { const bf16* qrow = F.QE + (size_t)(t0 + i0 + r) * 512 + h * 128 + 8 * hh;
#pragma unroll
      for (int ks = 0; ks < 8; ++ks) qf[ks] = *(const bf16x8*)(qrow + 16 * ks); }
    { const bf16* sp = F.SP + (size_t)u * 32768;
#pragma unroll
      for (int i = 0; i < 8; ++i) { const int piece = tid + 512 * i, row = piece >> 4, pc = piece & 15; *(LAS v4u*)(SIM + row * 272 + pc * 16) = *(const v4u*)(sp + row * 128 + pc * 8); } }
    __syncthreads();
    f32x16 acc[8];
#pragma unroll
    for (int vt = 0; vt < 8; ++vt)
#pragma unroll
        for (int i = 0; i < 16; ++i) acc[vt][i] = 0.f;
#pragma unroll
    for (int vt = 0; vt < 8; ++vt)
#pragma unroll
        for (int ks = 0; ks < 8; ++ks) acc[vt] = MFMA32(ldsb128(SIM + (32 * vt + r) * 272 + (16 * ks + 8 * hh) * 2), qf[ks], acc[vt]);
    __syncthreads();
#pragma unroll 1
    for (int jb = 0; jb < 4; ++jb) {
#pragma unroll
        for (int i = 0; i < 2; ++i) { const int piece = tid + 512 * i, row = piece >> 4, pc = piece & 15;
            *(LAS v4u*)(KIM + row * 272 + pc * 16) = *(const v4u*)(F.KE + (size_t)(t0 + 64 * jb + row) * 512 + h * 128 + pc * 8); }
#pragma unroll
        for (int i = 0; i < 4; ++i) { const int piece = tid + 512 * i, row = piece >> 5, pc = piece & 31;
            *(LAS v4u*)(VIM + row * 576 + pc * 16) = *(const v4u*)(F.P + (size_t)(t0 + 64 * jb + row) * NP_E + EC_VV + h * 256 + pc * 8); }
        __syncthreads();
#pragma unroll 1
        for (int jt = 0; jt < 2; ++jt) {
            const int j0 = 64 * jb + 32 * jt;
            if (j0 <= i0 + 31) {
                f32x16 X;
#pragma unroll
                for (int i = 0; i < 16; ++i) X[i] = 0.f;
#pragma unroll
                for (int ks = 0; ks < 8; ++ks) X = MFMA32(ldsb128(KIM + (32 * jt + r) * 272 + (16 * ks + 8 * hh) * 2), qf[ks], X);
                if (j0 + 31 > i0) {
#pragma unroll
                    for (int reg = 0; reg < 16; ++reg) X[reg] = (j0 + crow(reg, hh) > i0 + r) ? 0.f : X[reg];
                }
                const bf16x8 xs0 = pack8(X, 0), xs1 = pack8(X, 1);
#pragma unroll
                for (int vt = 0; vt < 8; ++vt) {
                    const LAS unsigned char* pa = VIM + (32 * jt + 4 * hh + q4) * 576 + (32 * vt + 16 * blk + 4 * p4) * 2;
                    acc[vt] = MFMA32(cat8(tr16(pa), tr16(pa + 8 * 576)), xs0, acc[vt]);
                    acc[vt] = MFMA32(cat8(tr16(pa + 16 * 576), tr16(pa + 24 * 576)), xs1, acc[vt]);
                }
            }
        }
        __syncthreads();
    }
    float ss = 0.f;
#pragma unroll
    for (int vt = 0; vt < 8; ++vt)
#pragma unroll
        for (int i = 0; i < 16; ++i) ss += acc[vt][i] * acc[vt][i];
    ss += __shfl_xor(ss, 32);
    const float rn = 1.f / sqrtf(ss * (1.f / 256.f) + EPS);
    const float* ong = F.in(I_BONG) + (size_t)li * 256;
    const bf16* rrow = F.P + (size_t)(t0 + i0 + r) * NP_E + EC_R + h * 256;
    bf16* orow = F.AB + (size_t)(t0 + i0 + r) * D + 1024 + h * 256;
#pragma unroll
    for (int vt = 0; vt < 8; ++vt)
#pragma unroll
        for (int g4 = 0; g4 < 4; ++g4) {
            const int v0 = 32 * vt + 8 * g4 + 4 * hh;
            const v2u rr = *(const v2u*)(rrow + v0); const f32x4 gg = *(const f32x4*)(ong + v0);
            const float r0 = bf_lo(rr.x), r1 = bf_hi(rr.x), r2 = bf_lo(rr.y), r3 = bf_hi(rr.y);
            const float o0 = acc[vt][4 * g4 + 0] * rn * gg.x * (r0 / (1.f + __expf(-r0))), o1 = acc[vt][4 * g4 + 1] * rn * gg.y * (r1 / (1.f + __expf(-r1)));
            const float o2 = acc[vt][4 * g4 + 2] * rn * gg.z * (r2 / (1.f + __expf(-r2))), o3 = acc[vt][4 * g4 + 3] * rn * gg.w * (r3 / (1.f + __expf(-r3)));
            v2u o; o.x = cvtpk(o0, o1); o.y = cvtpk(o2, o3);
            *(v2u*)(orow + v0) = o;
        }
}

__device__ __forceinline__ void sgu2_unit(Frame& F, int li, int u) {
    const int b = u >> 8, n = (u >> 3) & 31, g = u & 7, m0 = b * SEQ + n * 128;
    const int tid = F.tid_(), lane = F.lane_(), w = F.wave_(), r = lane & 31, hh = lane >> 5, blk = (lane >> 4) & 1, q4 = (lane >> 2) & 3, p4 = lane & 3;
    LAS unsigned char* VIM = F.lds;
    const int ct = w & 3, tp = w >> 2;
    const bf16* Wb = F.WSB + (size_t)(li * 8 + g) * 128 * 128;
    bf16x8 af[2][8]; unsigned short uu[2][16];
#pragma unroll
    for (int half = 0; half < 2; ++half) { const int tt = half ? 3 - tp : tp; const bf16* arow = Wb + (size_t)(32 * tt + r) * 128 + 8 * hh;
#pragma unroll
        for (int ks = 0; ks < 8; ++ks) af[half][ks] = *(const bf16x8*)(arow + 16 * ks);
#pragma unroll
        for (int reg = 0; reg < 16; ++reg) uu[half][reg] = F.P[(size_t)(m0 + 32 * tt + crow(reg, hh)) * NP_E + EC_U + 128 * g + 32 * ct + r]; }
    {
        const int s = tid >> 2, q = tid & 3;
        const v4u* row = (const v4u*)(F.P + (size_t)(m0 + s) * NP_E + EC_V + 128 * g + 32 * q);
        float x[32];
#pragma unroll
        for (int i = 0; i < 4; ++i) { const v4u wv = row[i]; x[8 * i + 0] = bf_lo(wv.x); x[8 * i + 1] = bf_hi(wv.x); x[8 * i + 2] = bf_lo(wv.y); x[8 * i + 3] = bf_hi(wv.y); x[8 * i + 4] = bf_lo(wv.z); x[8 * i + 5] = bf_hi(wv.z); x[8 * i + 6] = bf_lo(wv.w); x[8 * i + 7] = bf_hi(wv.w); }
        float sm = 0.f;
#pragma unroll
        for (int i = 0; i < 32; ++i) sm += x[i];
        sm += __shfl_xor(sm, 1); sm += __shfl_xor(sm, 2);
        const float mu = sm * (1.f / 128.f); float q2 = 0.f;
#pragma unroll
        for (int i = 0; i < 32; ++i) { x[i] -= mu; q2 += x[i] * x[i]; }
        q2 += __shfl_xor(q2, 1); q2 += __shfl_xor(q2, 2);
        const float rstd = 1.f / sqrtf(q2 * (1.f / 128.f) + EPS);
        const f32x4* lg = (const f32x4*)(F.in(I_AVLNG) + (size_t)(li * 8 + g) * 128 + 32 * q);
#pragma unroll
        for (int i = 0; i < 4; ++i) { const f32x4 g0 = lg[2 * i], g1 = lg[2 * i + 1]; v4u o;
            o.x = cvtpk(x[8 * i + 0] * rstd * g0.x, x[8 * i + 1] * rstd * g0.y); o.y = cvtpk(x[8 * i + 2] * rstd * g0.z, x[8 * i + 3] * rstd * g0.w);
            o.z = cvtpk(x[8 * i + 4] * rstd * g1.x, x[8 * i + 5] * rstd * g1.y); o.w = cvtpk(x[8 * i + 6] * rstd * g1.z, x[8 * i + 7] * rstd * g1.w);
            *(LAS v4u*)(VIM + s * 320 + (32 * q + 8 * i) * 2) = o; }
    }
    __syncthreads();
    const float* bbase = F.in(I_ABS) + (size_t)(li * 8 + g) * 128;
#pragma unroll
    for (int half = 0; half < 2; ++half) {
        const int tt = half ? 3 - tp : tp;
        f32x16 acc;
#pragma unroll
        for (int i = 0; i < 16; ++i) acc[i] = 0.f;
#pragma unroll
        for (int ks = 0; ks < 8; ++ks) {
            if (ks < 2 * (tt + 1)) {
                const LAS unsigned char* pb = VIM + (16 * ks + 8 * hh + q4) * 320 + (32 * ct + 16 * blk + 4 * p4) * 2;
                acc = MFMA32(af[half][ks], cat8(tr16(pb), tr16(pb + 4 * 320)), acc);
            }
        }
        const int c = 32 * ct + r;
#pragma unroll
        for (int reg = 0; reg < 16; ++reg) { const int t = 32 * tt + crow(reg, hh);
            F.AB[(size_t)(m0 + t) * D + 128 * g + c] = (bf16)f2bf(bf2f(uu[half][reg]) * (acc[reg] + bbase[t])); }
    }
    __syncthreads();
}

template <int NT> __device__ __forceinline__ void inproj_tail(Frame& F, const bf16* Wt  , const unsigned long long* rss, bf16* Pout  , int ldc) {
    typedef float f32x4v __attribute__((ext_vector_type(4)));
    const int lane = F.lane_(), w = F.wave_(), kq = w & 3, rh = w >> 2, l15 = lane & 15, kg = lane >> 4;
    LAS float* red = (LAS float*)F.lds;
    for (int rb = (int)blockIdx.x; rb < M / 64; rb += F.G) {
        const int m0 = rb * 64 + rh * 32;
        f32x4v acc[2][NT];
#pragma unroll
        for (int t = 0; t < 2; ++t)
#pragma unroll
            for (int ct = 0; ct < NT; ++ct) acc[t][ct] = (f32x4v){0.f, 0.f, 0.f, 0.f};
        const bf16* ap = F.HB + (size_t)(m0 + l15) * D + kq * 512 + 8 * kg;
        const bf16* bp = Wt + (size_t)l15 * D + kq * 512 + 8 * kg;
#pragma unroll 1
        for (int kk = 0; kk < 4; ++kk) {
            bf16x8 a[2][4], bfr[NT][4];
#pragma unroll
            for (int s = 0; s < 4; ++s) {
#pragma unroll
                for (int t = 0; t < 2; ++t) a[t][s] = *(const bf16x8*)(ap + (size_t)(16 * t) * D + 128 * kk + 32 * s);
#pragma unroll
                for (int ct = 0; ct < NT; ++ct) bfr[ct][s] = *(const bf16x8*)(bp + (size_t)(16 * ct) * D + 128 * kk + 32 * s);
            }
#pragma unroll
            for (int s = 0; s < 4; ++s)
#pragma unroll
                for (int t = 0; t < 2; ++t)
#pragma unroll
                    for (int ct = 0; ct < NT; ++ct) acc[t][ct] = __builtin_amdgcn_mfma_f32_16x16x32_bf16(a[t][s], bfr[ct][s], acc[t][ct], 0, 0, 0);
        }
        if (kq != 0) {
#pragma unroll
            for (int t = 0; t < 2; ++t)
#pragma unroll
                for (int ct = 0; ct < NT; ++ct) *(LAS f32x4v*)(red + (((((kq - 1) * 2 + rh) * 2 + t) * NT + ct) * 64 + lane) * 4) = acc[t][ct];
        }
        __syncthreads();
        if (kq == 0) {
#pragma unroll
            for (int t = 0; t < 2; ++t) {
                float rs[4];
#pragma unroll
                for (int i = 0; i < 4; ++i) rs[i] = rsqrtf((float)rss[m0 + 16 * t + 4 * kg + i] * (1.f / (65536.f * 2048.f)) + EPS);
#pragma unroll
                for (int ct = 0; ct < NT; ++ct) {
                    f32x4v o = acc[t][ct];
#pragma unroll
                    for (int q = 0; q < 3; ++q) o += *(const LAS f32x4v*)(red + ((((q * 2 + rh) * 2 + t) * NT + ct) * 64 + lane) * 4);
#pragma unroll
                    for (int i = 0; i < 4; ++i) Pout[(size_t)(m0 + 16 * t + 4 * kg + i) * ldc + 16 * ct + l15] = (bf16)f2bf(o[i] * rs[i]);
                }
            }
        }
        __syncthreads();
    }
}

#ifndef IDX_ASM_FMA
#define IDX_ASM_FMA 1
#endif
__device__ __forceinline__ unsigned f2key(float f) { const unsigned u = __builtin_bit_cast(unsigned, f); return u ^ ((unsigned)((int)u >> 31) | 0x80000000u); }
__device__ __forceinline__ void idx2_unit(Frame& F, int li, int u, const bool sel = true) {
    const int m0 = 16 * u, b = m0 / SEQ, tq0 = m0 % SEQ, tmax = tq0 + 15, nblk = (tmax >> 7) + 1;
    const int tid = F.tid_(), lane = F.lane_(), w = F.wave_(), r = lane & 31, hh = lane >> 5;
    const int tq = tq0 + 2 * w + hh;
    const int vlim = tq - r;
    const bf16* Pb = F.P + (size_t)b * SEQ * NP_O;
    LAS unsigned char* KB = F.lds;
    {
        const bf16* kr = F.P + (size_t)(m0 + 2 * w + (lane >> 5)) * NP_O + OC_K + ((lane >> 3) & 3) * 128 + (lane & 7) * 16;
        const v4u k0 = *(const v4u*)kr, k1 = *(const v4u*)(kr + 8);
        float s = dot2bf(k0.x, k0.x, 0.f); s = dot2bf(k0.y, k0.y, s); s = dot2bf(k0.z, k0.z, s); s = dot2bf(k0.w, k0.w, s);
        s = dot2bf(k1.x, k1.x, s); s = dot2bf(k1.y, k1.y, s); s = dot2bf(k1.z, k1.z, s); s = dot2bf(k1.w, k1.w, s);
        s += __shfl_xor(s, 1); s += __shfl_xor(s, 2); s += __shfl_xor(s, 4);
        s = fmaxf(s, __shfl_xor(s, 32));
        if (lane < 32 && (lane & 7) == 0) atomicMax(F.KMAX + li * 16 + b * 4 + (lane >> 3), __builtin_bit_cast(unsigned, s));
    }
    bf16x8 af[4];
    { const int qq = (r >> 2) & 1, hd = ((r >> 3) << 2) | (r & 3);
      const bf16* arow = F.P + (size_t)(m0 + 2 * w + qq) * NP_O + OC_IQ + hd * 64 + 8 * hh;
#pragma unroll
      for (int ks = 0; ks < 4; ++ks) af[ks] = *(const bf16x8*)(arow + 16 * ks); }
    float wv[16];
    { const bf16* wrow = F.P + (size_t)(m0 + 2 * w + hh) * NP_O + OC_IW; const v4u a = *(const v4u*)wrow, c = *(const v4u*)(wrow + 8);
      wv[0] = bf_lo(a.x); wv[1] = bf_hi(a.x); wv[2] = bf_lo(a.y); wv[3] = bf_hi(a.y); wv[4] = bf_lo(a.z); wv[5] = bf_hi(a.z); wv[6] = bf_lo(a.w); wv[7] = bf_hi(a.w);
      wv[8] = bf_lo(c.x); wv[9] = bf_hi(c.x); wv[10] = bf_lo(c.y); wv[11] = bf_hi(c.y); wv[12] = bf_lo(c.z); wv[13] = bf_hi(c.z); wv[14] = bf_lo(c.w); wv[15] = bf_hi(c.w); }
    unsigned key[128];
#pragma unroll
    for (int k = 0; k < 128; ++k) key[k] = 0u;
    v4u st[2];
    const int srow = tid >> 3, spc = tid & 7;
    const bf16* sbase = Pb + (size_t)srow * NP_O + OC_IK + spc * 8;
#pragma unroll
    for (int i = 0; i < 2; ++i) st[i] = *(const v4u*)(sbase + (size_t)(64 * i) * NP_O);
#pragma unroll
    for (int blk = 0; blk < 32; ++blk) {
        if (blk < nblk) {
            LAS unsigned char* kb = KB + (blk & 1) * 18432;
#pragma unroll
            for (int i = 0; i < 2; ++i) *(LAS v4u*)(kb + (srow + 64 * i) * 144 + spc * 16) = st[i];
            if (blk + 1 < nblk) {
#pragma unroll
                for (int i = 0; i < 2; ++i) st[i] = *(const v4u*)(sbase + (size_t)(128 * (blk + 1) + 64 * i) * NP_O);
            }
            __syncthreads();
            bf16x8 bq[4];
#pragma unroll
            for (int ks = 0; ks < 4; ++ks) bq[ks] = ldsb128(kb + r * 144 + (16 * ks + 8 * hh) * 2);
#pragma unroll
            for (int tl = 0; tl < 4; ++tl) {
                const int tt = 4 * blk + tl, j0 = 32 * tt;
                {
                    f32x16 X;
#pragma unroll
                    for (int i = 0; i < 16; ++i) X[i] = 0.f;
#pragma unroll
                    for (int ks = 0; ks < 4; ++ks) X = MFMA32(af[ks], bq[ks], X);
#ifdef IDX_PROBE_NOLDS
                    if (tl < 3 && sel) {
#else
                    if (tl < 3) {
#endif
#pragma unroll
                        for (int ks = 0; ks < 4; ++ks) bq[ks] = ldsb128(kb + (32 * (tl + 1) + r) * 144 + (16 * ks + 8 * hh) * 2);
                    }
                    float s0, s1, s2, s3;
#if IDX_ASM_FMA
#define IDX_ACC0(sv, hd_) do { const float x_ = X[hd_]; const float t_ = __builtin_bit_cast(float, max(__builtin_bit_cast(int, x_), 0)); asm("v_mul_f32 %0, %1, %2" : "=v"(sv) : "v"(wv[hd_]), "v"(t_)); } while (0)
                    IDX_ACC0(s0, 0); IDX_ACC0(s1, 1); IDX_ACC0(s2, 2); IDX_ACC0(s3, 3);
#undef IDX_ACC0
#else
                    s0 = s1 = s2 = s3 = 0.f;
#endif
#if IDX_ASM_FMA
#define IDX_ACC(sv, hd_) do { const float x_ = X[hd_];   const float t_ = __builtin_bit_cast(float, max(__builtin_bit_cast(int, x_), 0)); asm("v_fma_f32 %0, %1, %2, %0" : "+v"(sv) : "v"(wv[hd_]), "v"(t_)); } while (0)
#else
#define IDX_ACC(sv, hd_) do { const float x_ = X[hd_]; sv = fmaf(wv[hd_], __builtin_bit_cast(float, max(__builtin_bit_cast(int, x_), 0)), sv); } while (0)
#endif
#pragma unroll
                    for (int hd = IDX_ASM_FMA ? 4 : 0; hd < 16; hd += 4) { IDX_ACC(s0, hd); IDX_ACC(s1, hd + 1); IDX_ACC(s2, hd + 2); IDX_ACC(s3, hd + 3); }
#undef IDX_ACC
                    key[tt] = f2key((s0 + s1) + (s2 + s3)) & ~(unsigned)((vlim - j0) >> 31);
                    __builtin_amdgcn_sched_barrier(0);
                }
            }
        }
    }
    if (!sel) {
        unsigned x = 0u;
#pragma unroll
        for (int k = 0; k < 128; ++k) x ^= key[k];
        if (x == 0x9e3779b9u) F.CNT[0] = (int)x;
        __syncthreads();
        return;
    }
#if REP_IDX == 4
    for (int selrep_ = 0; selrep_ < 2; ++selrep_) {
#endif
    unsigned T = 0u; asm volatile("" : "+v"(T));
    bool done = (tq + 1 <= KSEL);
    if (tq0 + 2 * w + 2 > KSEL) {
#pragma unroll 1
        for (int bit = 31; bit >= 0; --bit) {
            const unsigned cand = T | (1u << bit);
            int c = 0;
#pragma unroll
            for (int grp = 0; grp < 8; ++grp) {
                if (4 * grp < nblk) {
#pragma unroll
                    for (int k = 0; k < 16; ++k) c += (key[16 * grp + k] >= cand) ? 1 : 0;
                }
            }
            c = half_sum_dpp(c, hh);
            T = (!done && c >= KSEL) ? cand : T;
            done = done || (c == KSEL);
            if (__all(done)) break;
        }
    }
    if (tq + 1 <= KSEL) T = 0u;
    else if (done) T -= 1u;
    int g0, g1;
    { int c = 0;
#pragma unroll
      for (int grp = 0; grp < 8; ++grp) {
          if (4 * grp < nblk) {
#pragma unroll
              for (int k = 0; k < 16; ++k) c += (key[16 * grp + k] > T) ? 1 : 0;
          }
      }
      c = half_sum_dpp(c, hh);
      g0 = __builtin_amdgcn_readlane(c, 0); g1 = __builtin_amdgcn_readlane(c, 32); }
    int rem0 = (tq0 + 2 * w + 1 > KSEL) ? KSEL - g0 : 0, rem1 = (tq0 + 2 * w + 2 > KSEL) ? KSEL - g1 : 0;
    unsigned mw0 = 0u, mw1 = 0u, mw2 = 0u, mw3 = 0u;
    if ((rem0 | rem1) == 0) {
#pragma unroll
        for (int blk = 0; blk < 32; ++blk) {
            if (blk < nblk) {
#pragma unroll
                for (int tl = 0; tl < 4; ++tl) {
                    const int tt = 4 * blk + tl;
                    const unsigned long long mg = __ballot(key[tt] > T);
                    const unsigned w0 = (unsigned)mg, w1 = (unsigned)(mg >> 32);
                    if (tt < 64) { WRITELANE(mw0, w0, tt & 63); WRITELANE(mw2, w1, tt & 63); } else { WRITELANE(mw1, w0, tt & 63); WRITELANE(mw3, w1, tt & 63); }
                }
            }
        }
    } else {
#pragma unroll
        for (int blk = 0; blk < 32; ++blk) {
            if (blk < nblk) {
#pragma unroll
                for (int tl = 0; tl < 4; ++tl) {
                    const int tt = 4 * blk + tl;
                    const unsigned long long mg = __ballot(key[tt] > T), me = __ballot(key[tt] == T);
                    unsigned e0 = (unsigned)me, e1 = (unsigned)(me >> 32);
                    while (__popc(e0) > rem0) e0 &= ~(0x80000000u >> __clz(e0));
                    while (__popc(e1) > rem1) e1 &= ~(0x80000000u >> __clz(e1));
                    rem0 -= __popc(e0); rem1 -= __popc(e1);
                    const unsigned w0 = (unsigned)mg | e0, w1 = (unsigned)(mg >> 32) | e1;
                    if (tt < 64) { WRITELANE(mw0, w0, tt & 63); WRITELANE(mw2, w1, tt & 63); } else { WRITELANE(mw1, w0, tt & 63); WRITELANE(mw3, w1, tt & 63); }
                    __builtin_amdgcn_sched_barrier(0);
                }
            }
        }
    }
    unsigned* mrow = F.MASK + (size_t)(m0 + 2 * w) * 128;
    mrow[lane] = mw0; mrow[64 + lane] = mw1; mrow[128 + lane] = mw2; mrow[192 + lane] = mw3;
#if REP_IDX == 4
    }
#endif
    __syncthreads();
}

#ifndef ATT_SETPRIO
#define ATT_SETPRIO 1
#endif
#if ATT_SETPRIO
#define ATT_PRIO(p) __builtin_amdgcn_s_setprio(p)
#else
#define ATT_PRIO(p) ((void)0)
#endif
__device__ __forceinline__ void attn2_unit(Frame& F, int li, int b, int kvh, int qb) {
    const int tid = F.tid_(), lane = F.lane_(), w = F.wave_(), r = lane & 31, hh = lane >> 5, blk = (lane >> 4) & 1, q4 = (lane >> 2) & 3, p4 = lane & 3;
    const int g = w & 3, qs = w >> 2, hq = kvh * 4 + g, i0 = 64 * qb + 32 * qs, ti = i0 + r;
    const size_t mrow = (size_t)b * SEQ + ti;
    const bf16* Pb = F.P + (size_t)b * SEQ * NP_O;
    constexpr int KST = 272, VST = 320, BUFB = 128 * KST + 128 * VST;
    LAS float* BT = (LAS float*)(F.lds + 2 * BUFB);
    constexpr float LOG2E = 1.4426950408889634f, SC = 0.08838834764831845f * LOG2E;
    { const int gg = tid >> 7, dist = tid & 127; BT[tid] = F.in(I_RELB)[(int)T5B[dist] * 16 + kvh * 4 + gg] * LOG2E; }
    bf16x8 qf[8];
    { const bf16* qrow = Pb + (size_t)ti * NP_O + OC_Q + hq * 128 + 8 * hh;
#pragma unroll
      for (int ks = 0; ks < 8; ++ks) qf[ks] = *(const bf16x8*)(qrow + 16 * ks); }
    float mi;
    { float qq = 0.f;
#pragma unroll
      for (int ks = 0; ks < 8; ++ks) { const v4u qv = __builtin_bit_cast(v4u, qf[ks]); qq = dot2bf(qv.x, qv.x, qq); qq = dot2bf(qv.y, qv.y, qq); qq = dot2bf(qv.z, qv.z, qq); qq = dot2bf(qv.w, qv.w, qq); }
      qq += __shfl_xor(qq, 32);
      const float k2 = __builtin_bit_cast(float, F.KMAX[li * 16 + b * 4 + kvh]);
      float bm = -INFINITY; const float* rb = F.in(I_RELB) + hq;
#pragma unroll 8
      for (int bk = 0; bk < 32; ++bk) bm = fmaxf(bm, rb[bk * 16]);
      mi = SC * sqrtf(qq * k2) + bm * LOG2E; }
    f32x16 o[4];
#pragma unroll
    for (int dt = 0; dt < 4; ++dt)
#pragma unroll
        for (int i = 0; i < 16; ++i) o[dt][i] = 0.f;
    float l_run = 0.f;
    const int nkb = (qb >> 1) + 1;
    const int srow = tid >> 4, spc = tid & 15;
    const bf16* sK = Pb + (size_t)srow * NP_O + OC_K + kvh * 128 + spc * 8;
    const bf16* sV = Pb + (size_t)srow * NP_O + OC_V + kvh * 128 + spc * 8;
    v4u st[8];
#pragma unroll
    for (int i = 0; i < 4; ++i) { st[i] = *(const v4u*)(sK + (size_t)(32 * i) * NP_O); st[4 + i] = *(const v4u*)(sV + (size_t)(32 * i) * NP_O); }
    const unsigned* mbase = F.MASK + mrow * 128;
    v4u mwn = *(const v4u*)mbase;
#pragma unroll 1
    for (int kb = 0; kb < nkb; ++kb) {
        LAS unsigned char* Kim = F.lds + (kb & 1) * BUFB; LAS unsigned char* Vim = Kim + 128 * KST;
#pragma unroll
        for (int i = 0; i < 4; ++i) { *(LAS v4u*)(Kim + (srow + 32 * i) * KST + spc * 16) = st[i]; *(LAS v4u*)(Vim + (srow + 32 * i) * VST + spc * 16) = st[4 + i]; }
        const v4u mw = mwn;
        if (kb + 1 < nkb) { const size_t off = (size_t)(128 * (kb + 1)) * NP_O;
#pragma unroll
            for (int i = 0; i < 4; ++i) { st[i] = *(const v4u*)(sK + off + (size_t)(32 * i) * NP_O); st[4 + i] = *(const v4u*)(sV + off + (size_t)(32 * i) * NP_O); }
            mwn = *(const v4u*)(mbase + 4 * (kb + 1)); }
        __syncthreads();
#pragma unroll
        for (int jt = 0; jt < 4; ++jt) {
            const int j0 = 128 * kb + 32 * jt;
            if (j0 <= i0 + 31) {
                f32x16 X;
#pragma unroll
                for (int i = 0; i < 16; ++i) X[i] = 0.f;
                ATT_PRIO(1);
#pragma unroll
                for (int ks = 0; ks < 8; ++ks) X = MFMA32(ldsb128(Kim + (32 * jt + r) * KST + (16 * ks + 8 * hh) * 2), qf[ks], X);
                ATT_PRIO(0);
                const unsigned word = (jt == 0 ? mw.x : jt == 1 ? mw.y : jt == 2 ? mw.z : mw.w) >> (4 * hh);
                if (j0 + 31 + 128 > i0) {
                    const LAS float* bt = BT + g * 128; const int dbase = ti - j0 - 4 * hh;
#pragma unroll
                    for (int reg = 0; reg < 16; ++reg) { int dd = dbase - ((reg & 3) + 8 * (reg >> 2)); dd = dd < 0 ? 0 : (dd > 127 ? 127 : dd); X[reg] = fmaf(X[reg], SC, bt[dd] - mi); }
                } else {
                    const float bfar = BT[g * 128 + 127] - mi;
#pragma unroll
                    for (int reg = 0; reg < 16; ++reg) X[reg] = fmaf(X[reg], SC, bfar);
                }
                float ls = 0.f;
#pragma unroll
                for (int reg = 0; reg < 16; ++reg) {
                    unsigned t; asm("v_bfe_i32 %0, %1, %2, 1" : "=v"(t) : "v"(word), "n"((reg & 3) + 8 * (reg >> 2)));
                    X[reg] = __builtin_bit_cast(float, __builtin_bit_cast(unsigned, __builtin_amdgcn_exp2f(X[reg])) & t); ls += X[reg]; }
                l_run += ls;
                const bf16x8 xs0 = pack8(X, 0), xs1 = pack8(X, 1);
                ATT_PRIO(1);
#pragma unroll
                for (int dt = 0; dt < 4; ++dt) {
                    const LAS unsigned char* pa = Vim + (32 * jt + 4 * hh + q4) * VST + (32 * dt + 16 * blk + 4 * p4) * 2;
                    o[dt] = MFMA32(cat8(tr16(pa), tr16(pa + 8 * VST)), xs0, o[dt]);
                    o[dt] = MFMA32(cat8(tr16(pa + 16 * VST), tr16(pa + 24 * VST)), xs1, o[dt]);
                }
                ATT_PRIO(0);
            }
        }
    }
    const float inv = 1.f / (l_run + __shfl_xor(l_run, 32));
    bf16* orow = F.AB + mrow * D + hq * 128;
#pragma unroll
    for (int dt = 0; dt < 4; ++dt)
#pragma unroll
        for (int g4 = 0; g4 < 4; ++g4) { v2u ov; ov.x = cvtpk(o[dt][4 * g4 + 0] * inv, o[dt][4 * g4 + 1] * inv); ov.y = cvtpk(o[dt][4 * g4 + 2] * inv, o[dt][4 * g4 + 3] * inv);
            *(v2u*)(orow + 32 * dt + 8 * g4 + 4 * hh) = ov; }
    __syncthreads();
}
__device__ __forceinline__ void attn2_phase(Frame& F, int li) {
    if (F.G == 256) {
        const int c = (int)blockIdx.x;
#pragma unroll 1
        for (int rr = 0; rr < 4; ++rr) { const int combo = c & 15, qsel = c >> 4, qb = (rr & 1) ? 16 * rr + 15 - qsel : 16 * rr + qsel; attn2_unit(F, li, combo >> 2, combo & 3, qb); }
    } else {
        for (int u = (int)blockIdx.x; u < 1024; u += F.G) attn2_unit(F, li, (u & 15) >> 2, u & 3, u >> 4);
    }
}

#ifndef MK_SPLIT
#define MK_SPLIT 0
#endif
constexpr int NPH = 2 + 7 * DEPTH;
#ifndef FFN_F8_WHOLE
#define FFN_F8_WHOLE 1
#endif
#ifndef F8_FFN1_MASK
#define F8_FFN1_MASK 0x8
#endif
#ifndef F8_FFN2_MASK
#define F8_FFN2_MASK 0xC
#endif
#ifndef FFN_HALVES
#define FFN_HALVES 1
#endif
#ifndef REP_PRO
#define REP_PRO 1
#endif
#ifndef REP_NORM
#define REP_NORM 1
#endif
#ifndef REP_INPROJ
#define REP_INPROJ 1
#endif
#ifndef REP_GLA
#define REP_GLA 1
#endif
#ifndef REP_IDX
#define REP_IDX 1
#endif
#ifndef REP_ATTN
#define REP_ATTN 1
#endif
#ifndef REP_FFN1
#define REP_FFN1 1
#endif
#define REPEAT(n) for (int rep_ = 0; rep_ < ((n) == 3 ? 2 : ((n) == 4 ? 1 : (n))); ++rep_)
#define IN(k) (lo <= (k) && (k) < hi)
#ifndef REP_BAR
#define REP_BAR 1
#endif
#define SEAM(k) do { if (IN(k) && IN((k) + 1)) { xcd_barrier(bar); if (REP_BAR > 1) xcd_barrier(bar); } } while (0)
template <int L> __device__ __forceinline__ void layer_body(Frame& F, const XcdBarrier& bar, const int lo, const int hi) {
        constexpr int pb = 1 + 7 * L, li = L >> 1; constexpr bool odd = (L & 1) != 0, f8 = ((F8_FFN2_MASK >> L) & 1) != 0, f81 = ((F8_FFN1_MASK >> L) & 1) != 0;
        if (IN(pb + 0)) {
            constexpr int NP = odd ? NP_O : NP_E, NMAIN = odd ? 4096 : 5120;
            const bf16* Wt = odd ? F.Wcin + (size_t)li * NP_O * D : F.Wabin + (size_t)li * NP_E * D;
            pg8::Gemm g{F.HB, Wt, M, NMAIN, D}; pg8::StaticOrder S; S.init(M, NMAIN, F.G, (int)blockIdx.x);
            pg8::EpiInProj E{F.P, NP, odd ? 0 : 2048, F.RSS + (size_t)(2 * L) * M};
            REPEAT(REP_INPROJ) pg8::gemm_phase<pg8::EpiInProj, pg8::StaticOrder, true, true>(F.lds, g, S, E);
            inproj_tail<odd ? 5 : 1>(F, Wt + (size_t)NMAIN * D, F.RSS + (size_t)(2 * L) * M, F.P + NMAIN, NP);
        }
        SEAM(pb + 0);
        if constexpr (!odd) {
            if (IN(pb + 1)) REPEAT(REP_GLA) { for (int u = (int)blockIdx.x; u < 256; u += F.G) gla_a_unit(F, li, u); }
            SEAM(pb + 1);
            if (IN(pb + 2)) REPEAT(REP_GLA) { gla_scan(F); for (int u = (int)blockIdx.x; u < 1024; u += F.G) sgu2_unit(F, li, u); }
            SEAM(pb + 2);
            if (IN(pb + 3)) REPEAT(REP_GLA) { for (int u = (int)blockIdx.x; u < 256; u += F.G) gla_c_unit(F, li, u); }
            SEAM(pb + 3);
        } else {
            if (IN(pb + 1)) REPEAT(REP_IDX) { int rr_ = 0; for (int u = (int)blockIdx.x; u < M / 16; u += F.G, ++rr_) idx2_unit(F, li, (rr_ & 1) ? (u & ~255) + 255 - (u & 255) : u, REP_IDX != 3 || rep_ == 0);   }
            SEAM(pb + 1);
            if (IN(pb + 2)) REPEAT(REP_ATTN) attn2_phase(F, li);
            SEAM(pb + 2);
        }
        if (IN(pb + 4)) {
            pg8::Gemm g{F.AB, odd ? F.Wcout + (size_t)li * D * D : F.Wabout + (size_t)li * D * D, M, D, D}; pg8::StaticOrder S; S.init(M, D, F.G, (int)blockIdx.x);
            pg8::EpiResBf16<false, f81> E{F.HB, D, F.RSS + (size_t)(2 * L + 1) * M, nullptr, (unsigned char*)F.DS  };
            pg8::gemm_phase<pg8::EpiResBf16<false, f81>, pg8::StaticOrder, true, true>(F.lds, g, S, E);
#if JIT_WEIGHTS
            convert_ffn(F, L, -1, f8, f81);
#endif
        }
        SEAM(pb + 4);
#if FFN_HALVES
        if (IN(pb + 5)) {
#define FFN_HALF(hf, MR, PRE, POST) do { \
            { pg8::Gemm g{f81 ? (const bf16*)((const unsigned char*)F.DS + (size_t)(hf) * (MR) * D) : F.HB + (size_t)(hf) * (MR) * D, F.Wf1 + (size_t)L * FF * D, (MR), FF, D, 127 - 9}; pg8::StaticOrder S; S.init((MR), FF, F.G, (int)blockIdx.x); \
              if constexpr (f8) { pg8::EpiRelu2F8 E{(unsigned char*)F.P + (size_t)(hf) * (MR) * FF, FF, F.RSS + (size_t)(2 * L + 1) * M + (size_t)(hf) * (MR)}; \
                  pg8::gemm_phase<pg8::EpiRelu2F8, pg8::StaticOrder, true, true, f81>(F.lds, g, S, E); } \
              else { pg8::EpiRelu2 E{F.P + (size_t)(hf) * (MR) * FF, FF, F.RSS + (size_t)(2 * L + 1) * M + (size_t)(hf) * (MR)}; \
                  pg8::gemm_phase<pg8::EpiRelu2, pg8::StaticOrder, true, true, f81>(F.lds, g, S, E); } } \
            xcd_barrier(bar); \
            PRE; \
            { pg8::Gemm g{f8 ? (const bf16*)((const unsigned char*)F.P + (size_t)(hf) * (MR) * FF) : F.P + (size_t)(hf) * (MR) * FF, F.Wf2 + (size_t)L * D * FF, (MR), D, FF}; pg8::StaticOrder S; S.init((MR), D, F.G, (int)blockIdx.x); \
              pg8::EpiResBf16<false> E{F.HB + (size_t)(hf) * (MR) * D, D, F.RSS + (size_t)(2 * L + 2) * M + (size_t)(hf) * (MR), nullptr}; \
              pg8::gemm_phase<pg8::EpiResBf16<false>, pg8::StaticOrder, true, true, f8>(F.lds, g, S, E); } \
            POST; } while (0)
#if JIT_WEIGHTS
#define FFN_TAIL do { if constexpr (L + 1 < DEPTH) convert_inout(F, L + 1); } while (0)
#else
#define FFN_TAIL (void)0
#endif
            if constexpr (f8 && FFN_F8_WHOLE) { FFN_HALF(0, M, (void)0, FFN_TAIL); }
            else { FFN_HALF(0, M / 2, (void)0, (void)0);
                   FFN_HALF(1, M / 2, (void)0, FFN_TAIL); }
#undef FFN_TAIL
#undef FFN_HALF
        }
#else
        if (IN(pb + 5)) {
            pg8::Gemm g{F.HB, F.Wf1 + (size_t)L * FF * D, M, FF, D}; pg8::StaticOrder S; S.init(M, FF, F.G, (int)blockIdx.x);
            pg8::EpiRelu2 E{F.P, FF, F.RSS + (size_t)(2 * L + 1) * M};
#if REP_FFN1 == 3
            { pg8::EpiNull E0{F.P}; pg8::gemm_phase<pg8::EpiNull, pg8::StaticOrder, true, true>(F.lds, g, S, E0); }
            pg8::gemm_phase<pg8::EpiRelu2, pg8::StaticOrder, true, true>(F.lds, g, S, E);
#else
            REPEAT(REP_FFN1) pg8::gemm_phase<pg8::EpiRelu2, pg8::StaticOrder, true, true>(F.lds, g, S, E);
#endif
        }
        SEAM(pb + 5);
        if (IN(pb + 6)) {
            pg8::Gemm g{F.P, F.Wf2 + (size_t)L * D * FF, M, D, FF}; pg8::StaticOrder S; S.init(M, D, F.G, (int)blockIdx.x);
            pg8::EpiResBf16<false> E{F.HB, D, F.RSS + (size_t)(2 * L + 2) * M, nullptr};
#if defined(REP_FFN2) && REP_FFN2 > 1
            { pg8::EpiResBf16<false> E2{F.AB, D, (unsigned long long*)F.IDX, nullptr}; pg8::gemm_phase<pg8::EpiResBf16<false>, pg8::StaticOrder, true, true>(F.lds, g, S, E2); }
#endif
            pg8::gemm_phase<pg8::EpiResBf16<false>, pg8::StaticOrder, true, true>(F.lds, g, S, E);
        }
#endif
        SEAM(pb + 6);
}
struct Args { const float* in[17]; float* out; unsigned char* ws; int ph_lo, ph_hi; };
__global__ void __launch_bounds__(NWAVES * 64, 2) fwd(Args args) {
    extern __shared__ __attribute__((aligned(16))) unsigned char lds_raw[];
    Frame F;
    F.lds = (LAS unsigned char*)lds_raw;
    F.MISC = (volatile LAS unsigned*)(F.lds + LDSCTL_OFF);
    F.G = gridDim.x;
    unsigned char* ws = args.ws;
    F.ctl = (gu32*)(ws + WS_CTL);
    F.out = args.out;
    F.Wabin = (bf16*)(ws + WS_WABIN); F.Wabout = (bf16*)(ws + WS_WABOUT); F.Wcin = (bf16*)(ws + WS_WCIN); F.Wcout = (bf16*)(ws + WS_WCOUT); F.Wf1 = (bf16*)(ws + WS_WF1); F.Wf2 = (bf16*)(ws + WS_WF2);
    F.HB = (bf16*)(ws + WS_HB); F.RSS = (unsigned long long*)(ws + WS_RSS); F.KMAX = (unsigned*)(ws + WS_KMAX); F.AB = (bf16*)(ws + WS_AB); F.P = (bf16*)(ws + WS_P); F.IDX = (int*)(ws + WS_IDX); F.CNT = (int*)(ws + WS_CNT);
    F.QE = (bf16*)(ws + WS_QE); F.KE = (bf16*)(ws + WS_KE); F.SP = (bf16*)(ws + WS_SP); F.DS = (float*)(ws + WS_DS); F.LAST = (float*)(ws + WS_LAST); F.MASK = (unsigned*)(ws + WS_MASK); F.WSB = (bf16*)(ws + WS_WSB);
    for (int u = F.tid_(); u < (LDS_BYTES - LDSCTL_OFF) / 4; u += NWAVES * 64) ((LAS unsigned*)(F.lds + LDSCTL_OFF))[u] = 0u;
    __syncthreads();
    if (F.tid_() < 17) { const unsigned long long p = (unsigned long long)args.in[F.tid_()]; F.MISC[32 + 2 * F.tid_()] = (unsigned)p; F.MISC[33 + 2 * F.tid_()] = (unsigned)(p >> 32); }
    __syncthreads();
    const int lo = args.ph_lo, hi = args.ph_hi;
    XcdBarrier bar = xcd_barrier_post((unsigned*)(F.ctl + CW_BAR) + (MK_SPLIT ? lo : 0) * XCD_BAR_WORDS, F.MISC + 8);

    if (IN(0)) REPEAT(REP_PRO) { p0_prologue(F); } SEAM(0);
    layer_body<0>(F, bar, lo, hi);
    layer_body<1>(F, bar, lo, hi);
    layer_body<2>(F, bar, lo, hi);
    layer_body<3>(F, bar, lo, hi);
    if (IN(NPH - 1)) final_norm_phase(F, F.in(I_FNG), F.RSS + (size_t)8 * M, F.HB, F.out);
#undef IN
#undef SEAM
}

extern "C" void kernel_launch(void* const* d_in, const int* in_sizes, int n_in, void* d_out, int out_size, void* d_ws, size_t ws_size, hipStream_t stream) {
    static int grid = 0;
    if (grid == 0) {
        if (n_in != 17 || in_sizes[0] != M * D || out_size != M * D || ws_size < WS_END) { fprintf(stderr, "kernel_launch: unexpected shapes (n_in %d, in0 %d, out %d, ws %zu < %zu); nothing launched\n", n_in, n_in > 0 ? in_sizes[0] : -1, out_size, ws_size, (size_t)WS_END); grid = -1; return; }
        int dev = 0, cus = 0, per_cu = 0;
        if (hipGetDevice(&dev) != hipSuccess || hipDeviceGetAttribute(&cus, hipDeviceAttributeMultiprocessorCount, dev) != hipSuccess) { grid = -1; return; }
        if (hipFuncSetAttribute((const void*)fwd, hipFuncAttributeMaxDynamicSharedMemorySize, LDS_BYTES) != hipSuccess) { fprintf(stderr, "kernel_launch: hipFuncSetAttribute failed\n"); grid = -1; return; }
        if (hipOccupancyMaxActiveBlocksPerMultiprocessor(&per_cu, (const void*)fwd, NWAVES * 64, LDS_BYTES) != hipSuccess || per_cu < 1) { fprintf(stderr, "kernel_launch: occupancy query reports %d\n", per_cu); }
        (void)hipGetLastError();
        grid = cus;
    }
    if (grid < 0) return;
    if (hipMemsetAsync((char*)d_ws + WS_CTL, 0, CTL_ZERO_BYTES, stream) != hipSuccess) return;
    Args a{};
    for (int i = 0; i < 17; ++i) a.in[i] = (const float*)d_in[i];
    a.out = (float*)d_out; a.ws = (unsigned char*)d_ws;
#if MK_SPLIT
    for (int p = 0; p < NPH; ++p) {
        if (p >= 1 && p < NPH - 1) { const int L = (p - 1) / 7, k = (p - 1) % 7; if ((L & 1) && k == 3) continue; }
        a.ph_lo = p; a.ph_hi = p + 1;
        hipLaunchKernelGGL(fwd, dim3(grid), dim3(NWAVES * 64), LDS_BYTES, stream, a);
    }
#else
    a.ph_lo = 0; a.ph_hi = NPH;
    hipLaunchKernelGGL(fwd, dim3(grid), dim3(NWAVES * 64), LDS_BYTES, stream, a);
#endif
}
```
